# Optimizing an MI355X kernel written in HIP

```python
import jax
import jax.numpy as jnp
from jax import lax
import numpy as np

D_MODEL = 1024
BATCH = 2
SEQ = 8192
DEPTH = 1

D_MIX = D_MODEL
D_POOL = D_MIX // 2
D_ATTN = D_MIX - D_POOL
POOL_WINDOWS = (2, 4, 8, 16)
N_POOL_GROUPS = len(POOL_WINDOWS)
POOL_GROUP_DIM = D_POOL // N_POOL_GROUPS
HEAD_DIM = 64
N_HEADS = D_ATTN // HEAD_DIM
DILATION_PAIRS = ((128, 1), (512, 4), (2048, 16))
Q_BLOCK = 128
D_PROJ_IN = D_POOL + 3 * D_ATTN
D_FF = 2816
N_MOD = 9
EPS = 1e-6

kernel_name = "hybrid_pool_dilated_attn_macaron_block"


def rmsnorm(x, g):
    xf = x.astype(jnp.float32)
    y = xf * lax.rsqrt(jnp.mean(xf * xf, axis=-1, keepdims=True) + EPS)
    return (y * g.astype(jnp.float32)).astype(x.dtype)


def modulate(n, shift, scale):
    return n * (1 + scale) + shift


def swiglu(n, w_gate, w_up, w_down):
    return (jax.nn.silu(n @ w_gate) * (n @ w_up)) @ w_down


def alibi_slopes(n_heads):
    return jnp.exp2(-8.0 * jnp.arange(1, n_heads + 1, dtype=jnp.float32) / n_heads)


def multiscale_pool(u, w_pool, pool_scale):
    B, S, C = u.shape
    uf = u.astype(jnp.float32)
    cs0 = jnp.pad(jnp.cumsum(uf, axis=1), ((0, 0), (1, 0), (0, 0)))
    t = jnp.arange(S)
    groups = []
    for g, w in enumerate(POOL_WINDOWS):
        sl = slice(g * POOL_GROUP_DIM, (g + 1) * POOL_GROUP_DIM)
        csg = cs0[..., sl]
        lower = jnp.pad(csg[:, :S + 1 - w], ((0, 0), (w - 1, 0), (0, 0)))
        count = jnp.minimum(t + 1, w).astype(jnp.float32)[None, :, None]
        mean = (csg[:, 1:] - lower) / count
        groups.append(mean - uf[..., sl])
    pooled = jnp.stack(groups, axis=2)
    y = jnp.einsum('bsgc,gcd->bsgd', pooled, w_pool.astype(jnp.float32)).reshape(B, S, C)
    return (y * pool_scale.astype(jnp.float32)).astype(u.dtype)


def dilated_attention(q, k, v):
    B, S, H, Dh = q.shape
    n_blk = S // Q_BLOCK
    slopes = alibi_slopes(H)
    scale = Dh ** -0.5

    def block(i):
        t0 = i * Q_BLOCK
        t = t0 + jnp.arange(Q_BLOCK)
        qb = lax.dynamic_slice_in_dim(q, t0, Q_BLOCK, axis=1).astype(jnp.float32) * scale
        mxs, dens, nums = [], [], []
        for window, dil in DILATION_PAIRS:
            dist = dil * jnp.arange(window // dil + 1)
            idx = t[:, None] - dist[None, :]
            valid = idx >= 0
            idx = jnp.maximum(idx, 0)
            kg = jnp.take(k, idx, axis=1).astype(jnp.float32)
            vg = jnp.take(v, idx, axis=1).astype(jnp.float32)
            s = jnp.einsum('bqhd,bqjhd->bqhj', qb, kg)
            s = s - slopes[:, None] * dist.astype(jnp.float32)[None, :]
            s = jnp.where(valid[None, :, None, :], s, -jnp.inf)
            mx = jnp.max(s, axis=-1)
            p = jnp.exp(s - mx[..., None])
            dens.append(jnp.sum(p, axis=-1))
            nums.append(jnp.einsum('bqhj,bqjhd->bqhd', p, vg))
            mxs.append(mx)
        m_all = jnp.stack(mxs)
        w_r = jnp.exp(m_all - jnp.max(m_all, axis=0))
        num = sum(w_r[r][..., None] * nums[r] for r in range(len(DILATION_PAIRS)))
        den = sum(w_r[r] * dens[r] for r in range(len(DILATION_PAIRS)))
        return (num / den[..., None]).astype(q.dtype)

    out = lax.map(block, jnp.arange(n_blk))
    return jnp.moveaxis(out, 0, 1).reshape(B, S, H, Dh)


def hybrid_mixer(n, w_in, w_pool, pool_scale, w_out):
    B, S, _ = n.shape
    z = n @ w_in
    u, q, k, v = jnp.split(z, [D_POOL, D_POOL + D_ATTN, D_POOL + 2 * D_ATTN], axis=-1)
    y_pool = multiscale_pool(u, w_pool, pool_scale)
    hs = (B, S, N_HEADS, HEAD_DIM)
    y_attn = dilated_attention(q.reshape(hs), k.reshape(hs), v.reshape(hs)).reshape(B, S, D_ATTN)
    return jnp.concatenate([y_pool, y_attn], axis=-1) @ w_out


def setup_inputs(seed: int = 0) -> dict:
    key = jax.random.key(seed)
    ks = jax.random.split(key, 20)
    f32 = jnp.float32
    L, D = DEPTH, D_MODEL

    def nrm(k, shape, fan_in, mult=1.0):
        return jax.random.normal(k, shape, f32) * (mult * fan_in ** -0.5)

    def gain(k, shape):
        return 1.0 + 0.05 * jax.random.normal(k, shape, f32)

    return {
        "x": jax.random.normal(ks[0], (BATCH, SEQ, D), f32),
        "c": jax.random.normal(ks[1], (BATCH, D), f32),
        "w_ada": nrm(ks[2], (L, D, N_MOD * D), D, 0.5),
        "b_ada": 0.02 * jax.random.normal(ks[3], (L, N_MOD * D), f32),
        "g_ffn1": gain(ks[4], (L, D)),
        "w1_gate": nrm(ks[5], (L, D, D_FF), D),
        "w1_up": nrm(ks[6], (L, D, D_FF), D),
        "w1_down": nrm(ks[7], (L, D_FF, D), D_FF),
        "g_mix": gain(ks[8], (L, D)),
        "w_in": nrm(ks[9], (L, D, D_PROJ_IN), D),
        "w_pool": nrm(ks[10], (L, N_POOL_GROUPS, POOL_GROUP_DIM, POOL_GROUP_DIM), POOL_GROUP_DIM),
        "pool_scale": gain(ks[11], (L, D_POOL)),
        "w_out": nrm(ks[12], (L, D_MIX, D), D_MIX),
        "g_ffn2": gain(ks[13], (L, D)),
        "w2_gate": nrm(ks[14], (L, D, D_FF), D),
        "w2_up": nrm(ks[15], (L, D, D_FF), D),
        "w2_down": nrm(ks[16], (L, D_FF, D), D_FF),
        "g_final": gain(ks[17], (D,)),
    }


def reference(x, c, w_ada, b_ada, g_ffn1, w1_gate, w1_up, w1_down, g_mix, w_in, w_pool,
              pool_scale, w_out, g_ffn2, w2_gate, w2_up, w2_down, g_final):
    h = x
    for l in range(DEPTH):
        mod = (jax.nn.silu(c) @ w_ada[l] + b_ada[l])[:, None, :]
        sh1, sc1, gt1, sh2, sc2, gt2, sh3, sc3, gt3 = jnp.split(mod, N_MOD, axis=-1)
        n = modulate(rmsnorm(h, g_ffn1[l]), sh1, sc1)
        h = h + 0.5 * gt1 * swiglu(n, w1_gate[l], w1_up[l], w1_down[l])
        n = modulate(rmsnorm(h, g_mix[l]), sh2, sc2)
        h = h + gt2 * hybrid_mixer(n, w_in[l], w_pool[l], pool_scale[l], w_out[l])
        n = modulate(rmsnorm(h, g_ffn2[l]), sh3, sc3)
        h = h + 0.5 * gt3 * swiglu(n, w2_gate[l], w2_up[l], w2_down[l])
    return rmsnorm(h, g_final)
```

```cpp
#include <hip/hip_runtime.h>
#include <hip/hip_cooperative_groups.h>
#include <cstdio>
#include <cstdint>
namespace cg = cooperative_groups;
namespace pg8 {
#define PG8_LAS __attribute__((address_space(3)))
typedef unsigned short bf16_t;
typedef short bf16x8 __attribute__((ext_vector_type(8)));
typedef float f32x4 __attribute__((ext_vector_type(4)));
typedef unsigned u32x4 __attribute__((ext_vector_type(4)));
constexpr int BM = 256, BK = 64, HALF = 128, HTB = HALF * BK * 2  , STAGE_BYTES = 8 * HTB, NXCD = 8, WGM = 8;

__host__ __device__ __forceinline__ int lds_byte(int r, int c) { const int st = (r >> 4) * 2 + (c >> 5), rr = r & 15, cc = c & 31, ob = rr * 64 + cc * 2; return st * 1024 + (ob ^ (((ob >> 9) & 1) << 5)); }
__host__ __device__ __forceinline__ void stage_rc(int b, int& R, int& C) { const int st = b / 1024, sb = b % 1024, swz = sb ^ (((sb >> 9) & 1) << 5); R = (st >> 1) * 16 + swz / 64; C = (st & 1) * 32 + (swz % 64) / 2; }
__host__ __device__ __forceinline__ int perm32(int rho) { const int n = rho >> 4, i = rho & 15; return 8 * (i >> 2) + 4 * n + (i & 3); }

struct Unit { int pm, pn; };
struct Gemm { const bf16_t* A; const bf16_t* Bt; int M, N, K; };

struct StaticOrder {
    int nM, nN, nwg, G, c;
    __host__ __device__ void init(int M, int N, int G_, int c_) { nM = M / BM; nN = N / BM; nwg = nM * nN; G = G_; c = c_; }
    __host__ __device__ bool next(int i, Unit& u) const {
        const long L = (long)i * G + c; if (L >= nwg) return false;
        int wgid = (int)L; { const int q = nwg / NXCD, r = nwg % NXCD, xcd = wgid % NXCD, off = wgid / NXCD; wgid = (xcd < r ? xcd * (q + 1) : r * (q + 1) + (xcd - r) * q) + off; }
        const int nig = WGM * nN, gid = wgid / nig, fm = gid * WGM, gsz = (nM - fm) < WGM ? (nM - fm) : WGM;
        u.pm = fm + ((wgid % nig) % gsz); u.pn = (wgid % nig) / gsz; return true;
    }
    __device__ __forceinline__ void a_ready(const Unit&) const {}
    __device__ __forceinline__ void done(const Unit&) const {}
};


__device__ __forceinline__ unsigned cvt_pk_bf16(float lo, float hi) { unsigned r; asm volatile("v_cvt_pk_bf16_f32 %0, %1, %2" : "=v"(r) : "v"(lo), "v"(hi)); return r; }
typedef float f32x2v __attribute__((ext_vector_type(2)));
__device__ __forceinline__ f32x2v swiglu2(f32x2v g, f32x2v u) { const f32x2v t = g * (-1.4426950408889634f); f32x2v e; e.x = __builtin_amdgcn_exp2f(t.x); e.y = __builtin_amdgcn_exp2f(t.y);
    const f32x2v d = e + 1.0f; f32x2v r; r.x = __builtin_amdgcn_rcpf(d.x); r.y = __builtin_amdgcn_rcpf(d.y); return (g * u) * r; }
__device__ __forceinline__ float silu_f(float g) { return g * __builtin_amdgcn_rcpf(1.0f + __builtin_amdgcn_exp2f(-1.4426950408889634f * g)); }

__device__ __forceinline__ float rstd_of(const float* ssq, int row) { return __builtin_amdgcn_rsqf(ssq[row] * (1.0f / 1024.0f) + 1e-6f); }
struct EpiSwiGLU {
    static constexpr bool PERM = true, AFTER_DRAIN = false;
    bf16_t* O; int ldc; const float* ssq; const float* bias; int bias_bstride; int rows_per_batch;
    __device__ __forceinline__ void operator()(const f32x4 (&acc)[2][2][4][2], const Unit& u, int wr, int wc, int fr, int fq) const {
        const int row0 = u.pm * BM + wr * 64 + fr, col0 = u.pn * HALF + wc * 32 + 8 * fq;
        const float* bp = bias + (size_t)((u.pm * BM) / rows_per_batch) * bias_bstride + u.pn * BM + wc * 32 + 8 * fq;
        const f32x4 bg0 = *(const f32x4*)(bp), bg1 = *(const f32x4*)(bp + 4), bu0 = *(const f32x4*)(bp + HALF), bu1 = *(const f32x4*)(bp + HALF + 4);
        float rsv[2][4];
#pragma unroll
        for (int ai = 0; ai < 2; ++ai)
#pragma unroll
            for (int m = 0; m < 4; ++m) rsv[ai][m] = rstd_of(ssq, row0 + ai * HALF + m * 16);
#pragma unroll
        for (int ai = 0; ai < 2; ++ai)
#pragma unroll
            for (int m = 0; m < 4; ++m) { const int row = row0 + ai * HALF + m * 16; bf16_t* rowp = O + (size_t)row * ldc + col0; const float rs = rsv[ai][m];
                const f32x4 g0 = acc[ai][0][m][0] * rs + bg0, g1 = acc[ai][0][m][1] * rs + bg1, u0 = acc[ai][1][m][0] * rs + bu0, u1 = acc[ai][1][m][1] * rs + bu1;
                u32x4 w;
                { const f32x2v a = swiglu2((f32x2v){g0[0], g0[1]}, (f32x2v){u0[0], u0[1]}), b = swiglu2((f32x2v){g0[2], g0[3]}, (f32x2v){u0[2], u0[3]});
                  const f32x2v c = swiglu2((f32x2v){g1[0], g1[1]}, (f32x2v){u1[0], u1[1]}), d = swiglu2((f32x2v){g1[2], g1[3]}, (f32x2v){u1[2], u1[3]});
                  w.x = cvt_pk_bf16(a.x, a.y); w.y = cvt_pk_bf16(b.x, b.y); w.z = cvt_pk_bf16(c.x, c.y); w.w = cvt_pk_bf16(d.x, d.y); }
                *(u32x4*)rowp = w; }
    }
};
struct EpiZ {
    static constexpr bool PERM = true, AFTER_DRAIN = false;
    bf16_t* O; int ldc; int sc_lo, sc_hi; float scale; const float* ssq; const float* bias; int bias_bstride; int rows_per_batch;
    __device__ __forceinline__ void operator()(const f32x4 (&acc)[2][2][4][2], const Unit& u, int wr, int wc, int fr, int fq) const {
        const int row0 = u.pm * BM + wr * 64 + fr, col0 = u.pn * BM + wc * 32 + 8 * fq;
        const float sc = (u.pn >= sc_lo && u.pn < sc_hi) ? scale : 1.0f;
        const float* bp = bias + (size_t)((u.pm * BM) / rows_per_batch) * bias_bstride + col0;
        f32x4 bv[2][2];
#pragma unroll
        for (int bj = 0; bj < 2; ++bj) { bv[bj][0] = *(const f32x4*)(bp + bj * HALF) * sc; bv[bj][1] = *(const f32x4*)(bp + bj * HALF + 4) * sc; }
        float rsv[2][4];
#pragma unroll
        for (int ai = 0; ai < 2; ++ai)
#pragma unroll
            for (int m = 0; m < 4; ++m) rsv[ai][m] = rstd_of(ssq, row0 + ai * HALF + m * 16) * sc;
#pragma unroll
        for (int ai = 0; ai < 2; ++ai)
#pragma unroll
            for (int m = 0; m < 4; ++m) { const int row = row0 + ai * HALF + m * 16; bf16_t* rowp = O + (size_t)row * ldc + col0; const float rs = rsv[ai][m];
#pragma unroll
                for (int bj = 0; bj < 2; ++bj) { const f32x4 v0 = acc[ai][bj][m][0] * rs + bv[bj][0], v1 = acc[ai][bj][m][1] * rs + bv[bj][1];
                    u32x4 w; w.x = cvt_pk_bf16(v0[0], v0[1]); w.y = cvt_pk_bf16(v0[2], v0[3]); w.z = cvt_pk_bf16(v1[0], v1[1]); w.w = cvt_pk_bf16(v1[2], v1[3]);
                    *(u32x4*)(rowp + bj * HALF) = w; } }
    }
};
template <bool BF> __device__ __forceinline__ void load_res8(const void* p, size_t off, f32x4& a, f32x4& b) {
    if (BF) { const u32x4 w = *(const u32x4*)((const bf16_t*)p + off);
        a = (f32x4){__builtin_bit_cast(float, w.x << 16), __builtin_bit_cast(float, w.x & 0xffff0000u), __builtin_bit_cast(float, w.y << 16), __builtin_bit_cast(float, w.y & 0xffff0000u)};
        b = (f32x4){__builtin_bit_cast(float, w.z << 16), __builtin_bit_cast(float, w.z & 0xffff0000u), __builtin_bit_cast(float, w.w << 16), __builtin_bit_cast(float, w.w & 0xffff0000u)}; }
    else { a = *(const f32x4*)((const float*)p + off); b = *(const f32x4*)((const float*)p + off + 4); }
}
struct EpiResidFinal {
    static constexpr bool PERM = true, AFTER_DRAIN = false;
    const bf16_t* res; float* out; const float* coef; int mod_bstride; float f; int ldc; int rows_per_batch; float* ssq; unsigned* cnt; const float* g; unsigned want;
    __device__ __forceinline__ void operator()(const f32x4 (&acc)[2][2][4][2], const Unit& u, int wr, int wc, int fr, int fq) const {
        const int row0 = u.pm * BM + wr * 64 + fr, col0 = u.pn * BM + wc * 32 + 8 * fq;
        const size_t boff = (size_t)((u.pm * BM) / rows_per_batch) * mod_bstride;
        f32x4 cv[2][2]; float fl = f; asm volatile("" : "+v"(fl));
#pragma unroll
        for (int bj = 0; bj < 2; ++bj)
#pragma unroll
            for (int n = 0; n < 2; ++n) cv[bj][n] = *(const f32x4*)(coef + boff + col0 + bj * HALF + n * 4) * fl;
        f32x4 h[2][4][2][2];
#pragma unroll
        for (int ai = 0; ai < 2; ++ai)
#pragma unroll
            for (int m = 0; m < 4; ++m) { const int row = row0 + ai * HALF + m * 16; const size_t off = (size_t)row * ldc + col0; float ss = 0.f;
#pragma unroll
                for (int bj = 0; bj < 2; ++bj) { f32x4 rr[2]; load_res8<true>(res, off + bj * HALF, rr[0], rr[1]);
#pragma unroll
                    for (int n = 0; n < 2; ++n) { const f32x4 hv = rr[n] + cv[bj][n] * acc[ai][bj][m][n]; h[ai][m][bj][n] = hv;
                        ss += (hv[0] * hv[0] + hv[1] * hv[1]) + (hv[2] * hv[2] + hv[3] * hv[3]); } }
                ss += __shfl_xor(ss, 16); ss += __shfl_xor(ss, 32);
                if (fq == 0) atomicAdd(ssq + row, ss); }
        asm volatile("s_waitcnt vmcnt(0)" ::: "memory");
        unsigned* cw = cnt + 64 * u.pm;
        if ((threadIdx.x & 63) == 0) __hip_atomic_fetch_add(cw, 1u, __ATOMIC_RELAXED, __HIP_MEMORY_SCOPE_AGENT);
        { unsigned sp = 0; while (__hip_atomic_load(cw, __ATOMIC_RELAXED, __HIP_MEMORY_SCOPE_AGENT) < want) { __builtin_amdgcn_s_sleep(2); if (++sp > (1u << 20)) break; } }
        asm volatile("" ::: "memory");
        f32x4 gv[2][2];
#pragma unroll
        for (int bj = 0; bj < 2; ++bj)
#pragma unroll
            for (int n = 0; n < 2; ++n) gv[bj][n] = *(const f32x4*)(g + col0 + bj * HALF + n * 4);
        float rsv[2][4];
#pragma unroll
        for (int ai = 0; ai < 2; ++ai)
#pragma unroll
            for (int m = 0; m < 4; ++m) { const float sq = __hip_atomic_load(ssq + row0 + ai * HALF + m * 16, __ATOMIC_RELAXED, __HIP_MEMORY_SCOPE_AGENT); rsv[ai][m] = __builtin_amdgcn_rsqf(sq * (1.0f / 1024.0f) + 1e-6f); }
#pragma unroll
        for (int ai = 0; ai < 2; ++ai)
#pragma unroll
            for (int m = 0; m < 4; ++m) { const int row = row0 + ai * HALF + m * 16; const size_t off = (size_t)row * ldc + col0;
                const float rs = rsv[ai][m];
#pragma unroll
                for (int bj = 0; bj < 2; ++bj)
#pragma unroll
                    for (int n = 0; n < 2; ++n) *(f32x4*)(out + off + bj * HALF + n * 4) = h[ai][m][bj][n] * rs * gv[bj][n]; }
    }
};
template <bool NEXT, bool RES_BF, bool OUT_BF> struct EpiResid {
    static constexpr bool PERM = true, AFTER_DRAIN = false;
    const void* res; void* out; const float* coef; int mod_bstride; float f; int ldc; int rows_per_batch; float* ssq_out; bf16_t* an; const float* g_next; const float* scale_next;
    __device__ __forceinline__ void operator()(const f32x4 (&acc)[2][2][4][2], const Unit& u, int wr, int wc, int fr, int fq) const {
        const int row0 = u.pm * BM + wr * 64 + fr, col0 = u.pn * BM + wc * 32 + 8 * fq;
        const size_t boff = (size_t)((u.pm * BM) / rows_per_batch) * mod_bstride;
        f32x4 cv[2][2], gm[2][2]; float fl = f; asm volatile("" : "+v"(fl));
#pragma unroll
        for (int bj = 0; bj < 2; ++bj)
#pragma unroll
            for (int n = 0; n < 2; ++n) { cv[bj][n] = *(const f32x4*)(coef + boff + col0 + bj * HALF + n * 4) * fl;
                if (NEXT) gm[bj][n] = *(const f32x4*)(g_next + col0 + bj * HALF + n * 4) * (*(const f32x4*)(scale_next + boff + col0 + bj * HALF + n * 4) + 1.0f); }
        constexpr int MB = RES_BF ? 4 : 2;
#pragma unroll
        for (int ai = 0; ai < 2; ++ai)
#pragma unroll
            for (int mb = 0; mb < 4; mb += MB) {
                u32x4 rb[MB][2]; f32x4 rf[MB][2][2];
#pragma unroll
                for (int mi = 0; mi < MB; ++mi)
#pragma unroll
                    for (int bj = 0; bj < 2; ++bj) { const size_t off = (size_t)(row0 + ai * HALF + (mb + mi) * 16) * ldc + col0 + bj * HALF;
                        if (RES_BF) rb[mi][bj] = *(const u32x4*)((const bf16_t*)res + off);
                        else { rf[mi][bj][0] = *(const f32x4*)((const float*)res + off); rf[mi][bj][1] = *(const f32x4*)((const float*)res + off + 4); } }
#pragma unroll
                for (int mi = 0; mi < MB; ++mi) { const int m = mb + mi; const int row = row0 + ai * HALF + m * 16; const size_t off = (size_t)row * ldc + col0; float ss = 0.f;
#pragma unroll
                    for (int bj = 0; bj < 2; ++bj) { f32x4 h[2];
                        if (RES_BF) { const u32x4 w = rb[mi][bj];
                            h[0] = (f32x4){__builtin_bit_cast(float, w.x << 16), __builtin_bit_cast(float, w.x & 0xffff0000u), __builtin_bit_cast(float, w.y << 16), __builtin_bit_cast(float, w.y & 0xffff0000u)};
                            h[1] = (f32x4){__builtin_bit_cast(float, w.z << 16), __builtin_bit_cast(float, w.z & 0xffff0000u), __builtin_bit_cast(float, w.w << 16), __builtin_bit_cast(float, w.w & 0xffff0000u)}; }
                        else { h[0] = rf[mi][bj][0]; h[1] = rf[mi][bj][1]; }
#pragma unroll
                        for (int n = 0; n < 2; ++n) { h[n] = h[n] + cv[bj][n] * acc[ai][bj][m][n]; ss += (h[n][0] * h[n][0] + h[n][1] * h[n][1]) + (h[n][2] * h[n][2] + h[n][3] * h[n][3]); }
                        if (OUT_BF) { u32x4 w; w.x = cvt_pk_bf16(h[0][0], h[0][1]); w.y = cvt_pk_bf16(h[0][2], h[0][3]); w.z = cvt_pk_bf16(h[1][0], h[1][1]); w.w = cvt_pk_bf16(h[1][2], h[1][3]);
                            *(u32x4*)((bf16_t*)out + off + bj * HALF) = w; }
                        else { *(f32x4*)((float*)out + off + bj * HALF) = h[0]; *(f32x4*)((float*)out + off + bj * HALF + 4) = h[1]; }
                        if (NEXT) { const f32x4 a0 = h[0] * gm[bj][0], a1 = h[1] * gm[bj][1];
                            u32x4 w; w.x = cvt_pk_bf16(a0[0], a0[1]); w.y = cvt_pk_bf16(a0[2], a0[3]); w.z = cvt_pk_bf16(a1[0], a1[1]); w.w = cvt_pk_bf16(a1[2], a1[3]);
                            *(u32x4*)(an + off + bj * HALF) = w; } }
                    ss += __shfl_xor(ss, 16); ss += __shfl_xor(ss, 32);
                    if (fq == 0) atomicAdd(ssq_out + row, ss); }
            }
    }
};

template <class Epi, class Sched, bool ALIGN_EPI = false, bool SP2 = false>
__device__ __forceinline__ void gemm_phase(PG8_LAS unsigned char* lds, const Gemm g, const Sched& S, const Epi& E) {
    const int tid = threadIdx.x, wid = __builtin_amdgcn_readfirstlane(tid >> 6), lane = tid & 63, wr = wid >> 2, wc = wid & 3, fr = lane & 15, fq = lane >> 4;
    const int K = g.K, nt = K / BK;
    unsigned voffA[2], voffB[2];
#pragma unroll
    for (int i = 0; i < 2; ++i) { int R, C; stage_rc(tid * 16 + i * 8192, R, C); const int Rb = Epi::PERM ? ((R & ~31) + perm32(R & 31)) : R;
        voffA[i] = (unsigned)(R * K + C) * 2u; voffB[i] = (unsigned)(Rb * K + C) * 2u; }
    const size_t kstep = (size_t)(BK * 2);
    const size_t hstep = (size_t)HALF * K * 2;
    const size_t tstep = 2 * hstep;
    const unsigned ldsw = (unsigned)wid * 1024u;
    const int aoff = lds_byte(wr * 64 + fr, fq * 8), boff = lds_byte(wc * 32 + fr, fq * 8);
#define PG8_SA(b, h) (((b) * 2 + (h)) * HTB)
#define PG8_SB(b, h) ((4 + (b) * 2 + (h)) * HTB)
#define PG8_STAGE(bufoff, gbase, voff) do { _Pragma("unroll") for (int _i = 0; _i < 2; ++_i) \
        __builtin_amdgcn_global_load_lds((const unsigned*)((const char*)(gbase) + (voff)[_i]), (PG8_LAS unsigned*)(lds + (bufoff) + ldsw + _i * 8192), 16, 0, 0); } while (0)
#define PG8_LDA(dst, b, h) do { _Pragma("unroll") for (int m = 0; m < 4; ++m) _Pragma("unroll") for (int k = 0; k < 2; ++k) dst[m][k] = *(const PG8_LAS bf16x8*)(lds + PG8_SA(b, h) + aoff + m * 2048 + k * 1024); } while (0)
#define PG8_LDB(dst, b, h) do { _Pragma("unroll") for (int n = 0; n < 2; ++n) _Pragma("unroll") for (int k = 0; k < 2; ++k) dst[n][k] = *(const PG8_LAS bf16x8*)(lds + PG8_SB(b, h) + boff + n * 2048 + k * 1024); } while (0)
#define PG8_MMA(ai, bj, At, Bt) do { __builtin_amdgcn_s_setprio(1); _Pragma("unroll") for (int m = 0; m < 4; ++m) _Pragma("unroll") for (int n = 0; n < 2; ++n) _Pragma("unroll") for (int k = 0; k < 2; ++k) \
        acc[ai][bj][m][n] = __builtin_amdgcn_mfma_f32_16x16x32_bf16(Bt[n][k], At[m][k], acc[ai][bj][m][n], 0, 0, 0); __builtin_amdgcn_s_setprio(0); } while (0)
#define PG8_WAIT_V(n) asm volatile("s_waitcnt vmcnt(" #n ")" ::: "memory")
#define PG8_WAIT_L(n) asm volatile("s_waitcnt lgkmcnt(" #n ")" ::: "memory")
#define PG8_BAR __builtin_amdgcn_s_barrier()
#define PG8_SCHED __builtin_amdgcn_sched_barrier(0)
    Unit cur, nxt; int ui = 0;
    if (!S.next(0, cur)) return;
    f32x4 acc[2][2][4][2];
#pragma unroll
    for (int a = 0; a < 2; ++a)
#pragma unroll
        for (int b = 0; b < 2; ++b)
#pragma unroll
            for (int m = 0; m < 4; ++m)
#pragma unroll
                for (int n = 0; n < 2; ++n) acc[a][b][m][n] = (f32x4){0.f, 0.f, 0.f, 0.f};
    bf16x8 At[4][2], B0[2][2], B1[2][2];
    const char* cA = (const char*)g.A + (size_t)cur.pm * tstep; const char* cB = (const char*)g.Bt + (size_t)cur.pn * tstep;
    S.a_ready(cur);
    if constexpr (SP2) {
        PG8_STAGE(PG8_SB(0, 0), cB, voffB); PG8_STAGE(PG8_SB(0, 1), cB + hstep, voffB); PG8_STAGE(PG8_SA(0, 0), cA, voffA); PG8_STAGE(PG8_SA(0, 1), cA + hstep, voffA);
        if (wr == 1) PG8_BAR;
        PG8_WAIT_V(2); PG8_BAR;
        PG8_STAGE(PG8_SB(1, 0), cB + kstep, voffB); PG8_STAGE(PG8_SA(1, 0), cA + kstep, voffA); PG8_STAGE(PG8_SB(1, 1), cB + hstep + kstep, voffB);
        PG8_WAIT_V(6); PG8_BAR;
    } else {
        PG8_STAGE(PG8_SB(0, 0), cB, voffB); PG8_STAGE(PG8_SA(0, 0), cA, voffA); PG8_STAGE(PG8_SB(0, 1), cB + hstep, voffB); PG8_STAGE(PG8_SA(0, 1), cA + hstep, voffA);
        if (wr == 1) PG8_BAR;
        PG8_WAIT_V(4); PG8_BAR;
        PG8_STAGE(PG8_SB(1, 0), cB + kstep, voffB); PG8_STAGE(PG8_SA(1, 0), cA + kstep, voffA); PG8_STAGE(PG8_SB(1, 1), cB + hstep + kstep, voffB);
        PG8_WAIT_V(6); PG8_BAR;
    }
    for (;;) {
        const bool has_next = S.next(ui + 1, nxt);
        const char* nA = has_next ? (const char*)g.A + (size_t)nxt.pm * tstep : cA; const char* nB = has_next ? (const char*)g.Bt + (size_t)nxt.pn * tstep : cB;
        for (int t = 0; t < nt; t += 2) {
            const bool last = (t == nt - 2);
            const char* a1 = cA + (size_t)(t + 1) * kstep;
            const char* a2 = last ? nA : cA + (size_t)(t + 2) * kstep; const char* b2 = last ? nB : cB + (size_t)(t + 2) * kstep;
            const char* a3 = a2 + kstep; const char* b3 = b2 + kstep;
            if (last && has_next) S.a_ready(nxt);
            if constexpr (SP2) {
            PG8_LDB(B0, 0, 0); PG8_LDB(B1, 0, 1); PG8_SCHED; PG8_LDA(At, 0, 0); PG8_STAGE(PG8_SA(1, 1), a1 + hstep, voffA);
            PG8_WAIT_V(8); PG8_WAIT_L(0); PG8_BAR; PG8_MMA(0, 0, At, B0); PG8_MMA(0, 1, At, B1); PG8_BAR; PG8_SCHED;
            PG8_LDA(At, 0, 1); PG8_STAGE(PG8_SB(0, 0), b2, voffB); PG8_STAGE(PG8_SB(0, 1), b2 + hstep, voffB); PG8_STAGE(PG8_SA(0, 0), a2, voffA);
            PG8_WAIT_V(8); PG8_WAIT_L(0); PG8_BAR; PG8_MMA(1, 0, At, B0); PG8_MMA(1, 1, At, B1); PG8_BAR; PG8_SCHED;
            PG8_LDB(B0, 1, 0); PG8_LDB(B1, 1, 1); PG8_SCHED; PG8_LDA(At, 1, 0); PG8_STAGE(PG8_SA(0, 1), a2 + hstep, voffA);
            PG8_WAIT_V(8); PG8_WAIT_L(0); PG8_BAR; PG8_MMA(0, 0, At, B0); PG8_MMA(0, 1, At, B1); PG8_BAR; PG8_SCHED;
            PG8_LDA(At, 1, 1); PG8_STAGE(PG8_SB(1, 0), b3, voffB); PG8_STAGE(PG8_SB(1, 1), b3 + hstep, voffB); PG8_STAGE(PG8_SA(1, 0), a3, voffA);
            PG8_WAIT_V(8); PG8_WAIT_L(0); PG8_BAR; PG8_MMA(1, 0, At, B0); PG8_MMA(1, 1, At, B1); PG8_BAR; PG8_SCHED;
            } else {
            PG8_LDB(B0, 0, 0); PG8_SCHED; PG8_LDA(At, 0, 0); PG8_STAGE(PG8_SA(1, 1), a1 + hstep, voffA);
            PG8_WAIT_L(8); PG8_BAR; PG8_WAIT_L(0); PG8_MMA(0, 0, At, B0); PG8_BAR; PG8_SCHED;
            PG8_LDB(B1, 0, 1); PG8_STAGE(PG8_SB(0, 0), b2, voffB);
            PG8_BAR; PG8_WAIT_L(0); PG8_MMA(0, 1, At, B1); PG8_BAR;
            PG8_LDA(At, 0, 1); PG8_STAGE(PG8_SA(0, 0), a2, voffA);
            PG8_BAR; PG8_WAIT_L(0); PG8_MMA(1, 0, At, B0); PG8_BAR; PG8_SCHED;
            PG8_STAGE(PG8_SB(0, 1), b2 + hstep, voffB);
            PG8_WAIT_V(6); PG8_BAR; PG8_MMA(1, 1, At, B1); PG8_BAR;
            PG8_LDB(B0, 1, 0); PG8_SCHED; PG8_LDA(At, 1, 0); PG8_STAGE(PG8_SA(0, 1), a2 + hstep, voffA);
            PG8_WAIT_L(8); PG8_BAR; PG8_WAIT_L(0); PG8_MMA(0, 0, At, B0); PG8_BAR; PG8_SCHED;
            PG8_LDB(B1, 1, 1); PG8_STAGE(PG8_SB(1, 0), b3, voffB);
            PG8_BAR; PG8_WAIT_L(0); PG8_MMA(0, 1, At, B1); PG8_BAR;
            PG8_LDA(At, 1, 1); PG8_STAGE(PG8_SA(1, 0), a3, voffA);
            PG8_BAR; PG8_WAIT_L(0); PG8_MMA(1, 0, At, B0); PG8_BAR; PG8_SCHED;
            PG8_STAGE(PG8_SB(1, 1), b3 + hstep, voffB);
            PG8_WAIT_V(6); PG8_BAR; PG8_MMA(1, 1, At, B1); PG8_BAR;
            }
        }
        if constexpr (ALIGN_EPI) { if (wr == 0) PG8_BAR; }
        if constexpr (!Epi::AFTER_DRAIN) { E(acc, cur, wr, wc, fr, fq); S.done(cur); }
        if (!has_next) break;
#pragma unroll
        for (int a = 0; a < 2; ++a)
#pragma unroll
            for (int b = 0; b < 2; ++b)
#pragma unroll
                for (int m = 0; m < 4; ++m)
#pragma unroll
                    for (int n = 0; n < 2; ++n) acc[a][b][m][n] = (f32x4){0.f, 0.f, 0.f, 0.f};
        cur = nxt; cA = nA; cB = nB; ++ui;
        if constexpr (ALIGN_EPI) { if (wr == 1) PG8_BAR; }
    }
    PG8_WAIT_V(0);
    if constexpr (!ALIGN_EPI) { if (wr == 0) PG8_BAR; }
    PG8_BAR;
    if constexpr (Epi::AFTER_DRAIN) { E.fused(acc, cur, wr, wc, fr, fq, lds, wid, lane); S.done(cur); }
#undef PG8_SA
#undef PG8_SB
#undef PG8_STAGE
#undef PG8_LDA
#undef PG8_LDB
#undef PG8_MMA
#undef PG8_WAIT_V
#undef PG8_WAIT_L
#undef PG8_BAR
#undef PG8_SCHED
}
}

constexpr int BATCH = 2, SEQ = 8192, D = 1024, M = BATCH * SEQ, DFF = 2816, DZ = 2048, DPOOL = 512, DATT = 512, NH = 8, HD = 64, NMOD = 9;
constexpr float EPS = 1e-6f, LOG2E = 1.4426950408889634f, QSCALE = 0.125f * LOG2E;
constexpr int NWAVES = 8, NTHREADS = NWAVES * 64;
#define LAS __attribute__((address_space(3)))
typedef unsigned short bf16;
typedef short bf16x8 __attribute__((ext_vector_type(8)));
typedef short s16x4 __attribute__((ext_vector_type(4)));
typedef float f32x4 __attribute__((ext_vector_type(4)));
typedef float f32x16 __attribute__((ext_vector_type(16)));
typedef unsigned u32x4 __attribute__((ext_vector_type(4)));
typedef unsigned u32x2 __attribute__((ext_vector_type(2)));
typedef float f32x2_t __attribute__((ext_vector_type(2))); typedef __bf16 bf16x2_t __attribute__((ext_vector_type(2)));
__device__ __forceinline__ unsigned cvtpk(float lo, float hi) { f32x2_t v = {lo, hi}; bf16x2_t b = __builtin_convertvector(v, bf16x2_t); return __builtin_bit_cast(unsigned, b); }
__device__ __forceinline__ float bf_lo(unsigned w) { return __builtin_bit_cast(float, w << 16); }
__device__ __forceinline__ float bf_hi(unsigned w) { return __builtin_bit_cast(float, w & 0xffff0000u); }
__device__ __forceinline__ float wave_sum(float v) {
#pragma unroll
    for (int o = 1; o < 64; o <<= 1) v += __shfl_xor(v, o);
    return v;
}

constexpr size_t MiB = 1u << 20;
constexpr size_t WS_BAR = 512 * 1024, WS_BAR_BYTES = 16384;
constexpr size_t WS_QCTR = WS_BAR + 15360;
constexpr size_t WS_SSQ = 600 * 1024;
constexpr size_t WS_CNT = 860 * 1024;
constexpr size_t WS_BIAS = 900 * 1024;
constexpr size_t WS_MOD = 0;
constexpr size_t WS_W1GU = 1 * MiB, WS_W1D = 12 * MiB, WS_WIN = 18 * MiB, WS_WOUT = 22 * MiB, WS_W2GU = 24 * MiB, WS_W2D = 35 * MiB;
constexpr size_t WS_XN = 48 * MiB;
constexpr size_t WS_HID = 80 * MiB;
constexpr size_t WS_Z = 80 * MiB;
constexpr size_t WS_OBR = 144 * MiB;
constexpr size_t WS_ML = 41 * MiB;
constexpr size_t WS_YC = 192 * MiB;
constexpr size_t WS_HB = 224 * MiB;
constexpr size_t WS_END = 256 * MiB;

__device__ __forceinline__ void ada_phase(const float* c, const float* w_ada, const float* b_ada, float* mod, LAS unsigned char* lds) {
    LAS float* sc = (LAS float*)(lds + 81920);
    LAS float* red = sc + 2048;
    const int tid = threadIdx.x, lane = tid & 63, wave = tid >> 6;
    for (int item = blockIdx.x; item < (NMOD * D) / 64; item += gridDim.x) {
        for (int i = tid; i < 2 * D; i += NTHREADS) { const float v = c[i]; sc[i] = v * __builtin_amdgcn_rcpf(1.0f + __builtin_amdgcn_exp2f(-LOG2E * v)); }
        __syncthreads();
        const int cgp = item >> 2, kq = item & 3, col = cgp * 256 + 4 * lane, k0 = kq * 256 + wave * 32;
        const float* wp = w_ada + (size_t)k0 * (NMOD * D) + col;
        f32x4 wv[32];
#pragma unroll
        for (int k = 0; k < 32; ++k) wv[k] = *(const f32x4*)(wp + (size_t)k * (NMOD * D));
        f32x4 a0 = {0.f, 0.f, 0.f, 0.f}, a1 = {0.f, 0.f, 0.f, 0.f};
#pragma unroll
        for (int k = 0; k < 32; ++k) { a0 += wv[k] * sc[k0 + k]; a1 += wv[k] * sc[D + k0 + k]; }
        *(LAS f32x4*)(red + (wave * 2 + 0) * 256 + 4 * lane) = a0; *(LAS f32x4*)(red + (wave * 2 + 1) * 256 + 4 * lane) = a1;
        __syncthreads();
        { const int b = tid >> 8, cc = tid & 255; float s_ = 0.f;
#pragma unroll
          for (int w = 0; w < 8; ++w) s_ += red[(w * 2 + b) * 256 + cc];
          if (kq == 0) s_ += b_ada[cgp * 256 + cc];
          atomicAdd(mod + b * (NMOD * D) + cgp * 256 + cc, s_); }
        __syncthreads();
    }
}
__device__ __forceinline__ void tr_item(const float* W, int ldw, int k0, int n0, bf16* WT, int Kd, int drow0, LAS float* scr, int lane) {
    const int lr = lane >> 3, lc = 4 * (lane & 7);
    f32x4 v[8];
#pragma unroll
    for (int i = 0; i < 8; ++i) v[i] = *(const f32x4*)(W + (size_t)(k0 + lr + 8 * i) * ldw + n0 + lc);
#pragma unroll
    for (int i = 0; i < 8; ++i) { LAS float* d = scr + (lr + 8 * i) * 33 + lc; d[0] = v[i][0]; d[1] = v[i][1]; d[2] = v[i][2]; d[3] = v[i][3]; }
    asm volatile("s_waitcnt lgkmcnt(0)" ::: "memory");
    const int c = lane & 7;
#pragma unroll
    for (int j = 0; j < 4; ++j) { const int n = (lane >> 3) + 8 * j; const LAS float* s = scr + (8 * c) * 33 + n;
        u32x4 o; o.x = cvtpk(s[0 * 33], s[1 * 33]); o.y = cvtpk(s[2 * 33], s[3 * 33]); o.z = cvtpk(s[4 * 33], s[5 * 33]); o.w = cvtpk(s[6 * 33], s[7 * 33]);
        *(u32x4*)(WT + (size_t)(drow0 + n) * Kd + k0 + 8 * c) = o; }
    asm volatile("s_waitcnt lgkmcnt(0)" ::: "memory");
}
__device__ __forceinline__ void fold_item(const float* w_in, const float* w_pool, const float* pool_scale, bf16* WT, int r, LAS float* scr, int lane) {
    const int g = r >> 7, kb = (r >> 3) & 15, cb = r & 7, k = kb * 64 + lane;
    const float* wp = w_pool + (size_t)g * 128 * 128 + cb * 16;
#pragma unroll
    for (int i = 0; i < 8; ++i) { const int j = (lane >> 2) + 16 * i, c4 = 4 * (lane & 3); *(LAS f32x4*)(scr + j * 16 + c4) = *(const f32x4*)(wp + (size_t)j * 128 + c4); }
    asm volatile("s_waitcnt vmcnt(0) lgkmcnt(0)" ::: "memory");
    f32x4 acc[4];
#pragma unroll
    for (int c = 0; c < 4; ++c) acc[c] = (f32x4){0.f, 0.f, 0.f, 0.f};
    const float* wrow = w_in + (size_t)k * DZ + 128 * g;
#pragma unroll 2
    for (int j = 0; j < 128; j += 4) { const f32x4 av = *(const f32x4*)(wrow + j);
#pragma unroll
        for (int jj = 0; jj < 4; ++jj)
#pragma unroll
            for (int c = 0; c < 4; ++c) acc[c] += av[jj] * *(const LAS f32x4*)(scr + (j + jj) * 16 + 4 * c); }
#pragma unroll
    for (int c = 0; c < 16; ++c) { const int col = 128 * g + 16 * cb + c; const float v = acc[c >> 2][c & 3] * pool_scale[col];
        WT[(size_t)col * D + k] = (bf16)(cvtpk(v, v) & 0xffffu); }
    asm volatile("s_waitcnt lgkmcnt(0)" ::: "memory");
}
struct WPtrs { const float *w1g, *w1u, *w1d, *w_in, *w_pool, *pool_scale, *w_out, *w2g, *w2u, *w2d; bf16 *W1GU, *W1D, *WIN, *WOUT, *W2GU, *W2D; };
constexpr int I_FOLD = 512, I_GU = (D / 64) * (DFF / 32), I_DN = (DFF / 64) * (D / 32), I_IN = (D / 64) * ((DZ - DPOOL) / 32), I_OUT = (D / 64) * (D / 32);
constexpr int NITEMS = I_FOLD + 4 * I_GU + 2 * I_DN + I_IN + I_OUT;
constexpr int N_EARLY = 2 * I_GU + I_DN, N_LATE = NITEMS - N_EARLY;
__device__ __forceinline__ void conv_item(const WPtrs& P, int r, LAS float* scr, int lane) {
    if (r >= NITEMS - I_FOLD) { fold_item(P.w_in, P.w_pool, P.pool_scale, P.WIN, r - (NITEMS - I_FOLD), scr, lane); return; }
    if (r < 4 * I_GU) { const int which = r / I_GU; r -= which * I_GU; const int kb = r / (DFF / 32), nb = r % (DFF / 32), n0 = 32 * nb;
        const float* W = which == 0 ? P.w1g : which == 1 ? P.w1u : which == 2 ? P.w2g : P.w2u; bf16* WT = which < 2 ? P.W1GU : P.W2GU;
        tr_item(W, DFF, 64 * kb, n0, WT, D, 256 * (n0 >> 7) + (n0 & 127) + 128 * (which & 1), scr, lane); return; }
    r -= 4 * I_GU;
    if (r < 2 * I_DN) { const int which = r / I_DN; r -= which * I_DN; const int kb = r / (D / 32), nb = r % (D / 32);
        tr_item(which ? P.w2d : P.w1d, D, 64 * kb, 32 * nb, which ? P.W2D : P.W1D, DFF, 32 * nb, scr, lane); return; }
    r -= 2 * I_DN;
    if (r < I_IN) { const int kb = r / ((DZ - DPOOL) / 32), nb = r % ((DZ - DPOOL) / 32), n0 = DPOOL + 32 * nb;
        tr_item(P.w_in, DZ, 64 * kb, n0, P.WIN, D, n0, scr, lane); return; }
    r -= I_IN; { const int kb = r / (D / 32), nb = r % (D / 32); tr_item(P.w_out, D, 64 * kb, 32 * nb, P.WOUT, D, 32 * nb, scr, lane); }
}
__device__ __forceinline__ int early_item(int a) { return a < 2 * I_GU ? a : 4 * I_GU + (a - 2 * I_GU); }
__device__ __forceinline__ int late_item(int b) { return b < 2 * I_GU ? 2 * I_GU + b : (b < 2 * I_GU + I_DN ? 4 * I_GU + I_DN + (b - 2 * I_GU) : 4 * I_GU + 2 * I_DN + (b - 2 * I_GU - I_DN)); }
__device__ __forceinline__ void weights_early(const WPtrs& P, LAS unsigned char* lds) {
    const int lane = threadIdx.x & 63, wave = __builtin_amdgcn_readfirstlane(threadIdx.x >> 6);
    LAS float* scr = (LAS float*)(lds + wave * 9216);
    const bool bal = (gridDim.x == 256);
    const int nada = (NMOD * D) / 64, isada = (int)blockIdx.x < nada;
    const int w0 = bal ? (isada ? (int)blockIdx.x * NWAVES + wave : 2 * nada * NWAVES + ((int)blockIdx.x - nada) * NWAVES + wave) : (int)blockIdx.x * NWAVES + wave;
    const int wstep = bal ? (isada ? nada * NWAVES : (256 - nada) * NWAVES) : (int)gridDim.x * NWAVES;
    const int wend = bal ? (isada ? 2 * nada * NWAVES : N_EARLY) : N_EARLY;
    for (int a = w0; a < wend; a += wstep) conv_item(P, early_item(a), scr, lane);
}
__device__ __forceinline__ void weights_late(const WPtrs& P, int b0, LAS unsigned char* lds) {
    const int lane = threadIdx.x & 63, wave = __builtin_amdgcn_readfirstlane(threadIdx.x >> 6);
    LAS float* scr = (LAS float*)(lds + wave * 9216);
    if ((int)blockIdx.x < b0) return;
    for (int b = ((int)blockIdx.x - b0) * NWAVES + wave; b < N_LATE; b += ((int)gridDim.x - b0) * NWAVES) conv_item(P, late_item(b), scr, lane);
}

__device__ __forceinline__ void prep_rows_phase(const float* h, const float* g, const float* scale, bf16* XN, float* ssq) {
    const int lane = threadIdx.x & 63, wave = threadIdx.x >> 6, gw = blockIdx.x * NWAVES + wave, NGW = gridDim.x * NWAVES;
    f32x4 gg[4];
#pragma unroll
    for (int j = 0; j < 4; ++j) gg[j] = *(const f32x4*)(g + 4 * (64 * j + lane));
    for (int m0 = gw; m0 < M; m0 += 4 * NGW) {
        f32x4 v[4][4];
#pragma unroll
        for (int k = 0; k < 4; ++k) { const int m = m0 + k * NGW; const f32x4* xr = (const f32x4*)(h + (size_t)(m < M ? m : m0) * D) + lane;
#pragma unroll
            for (int j = 0; j < 4; ++j) v[k][j] = xr[64 * j]; }
#pragma unroll
        for (int k = 0; k < 4; ++k) { const int m = m0 + k * NGW; if (m < M) { const int b = m / SEQ; float s = 0.f;
#pragma unroll
            for (int j = 0; j < 4; ++j) s += (v[k][j].x * v[k][j].x + v[k][j].y * v[k][j].y) + (v[k][j].z * v[k][j].z + v[k][j].w * v[k][j].w);
            s = wave_sum(s); if (lane == 0) ssq[m] = s;
            unsigned long long* o8 = (unsigned long long*)(XN + (size_t)m * D) + lane;
#pragma unroll
            for (int j = 0; j < 4; ++j) { const int c = 4 * (64 * j + lane);
                const f32x4 sc = *(const f32x4*)(scale + b * (NMOD * D) + c);
                const f32x4 n = v[k][j] * gg[j] * (sc + 1.0f);
                o8[64 * j] = (unsigned long long)cvtpk(n.x, n.y) | ((unsigned long long)cvtpk(n.z, n.w) << 32); } } }
    }
}
__device__ __forceinline__ void bias_rows(const bf16* WT, int N, const float* shift, float* bias, int gw, int NGW, int lane) {
    f32x4 s0[4], s1[4];
#pragma unroll
    for (int j = 0; j < 4; ++j) { s0[j] = *(const f32x4*)(shift + 16 * lane + 4 * j); s1[j] = *(const f32x4*)(shift + NMOD * D + 16 * lane + 4 * j); }
    for (int n0 = gw; n0 < N; n0 += 4 * NGW) {
        u32x4 w0[4], w1[4];
#pragma unroll
        for (int j = 0; j < 4; ++j) { const int n = n0 + j * NGW; const int nc = n < N ? n : n0; w0[j] = *(const u32x4*)(WT + (size_t)nc * D + 16 * lane); w1[j] = *(const u32x4*)(WT + (size_t)nc * D + 16 * lane + 8); }
#pragma unroll
        for (int j = 0; j < 4; ++j) { const int n = n0 + j * NGW;
            const float f[16] = {bf_lo(w0[j].x), bf_hi(w0[j].x), bf_lo(w0[j].y), bf_hi(w0[j].y), bf_lo(w0[j].z), bf_hi(w0[j].z), bf_lo(w0[j].w), bf_hi(w0[j].w),
                                 bf_lo(w1[j].x), bf_hi(w1[j].x), bf_lo(w1[j].y), bf_hi(w1[j].y), bf_lo(w1[j].z), bf_hi(w1[j].z), bf_lo(w1[j].w), bf_hi(w1[j].w)};
            float a0 = 0.f, a1 = 0.f;
#pragma unroll
            for (int q = 0; q < 4; ++q)
#pragma unroll
                for (int e = 0; e < 4; ++e) { a0 += f[4 * q + e] * s0[q][e]; a1 += f[4 * q + e] * s1[q][e]; }
            a0 = wave_sum(a0); a1 = wave_sum(a1);
            if (lane == 0 && n < N) { bias[n] = a0; bias[N + n] = a1; } }
    }
}
__device__ __forceinline__ void final_norm_phase(const float* h, const float* g, const float* ssq, float* out) {
    const int lane = threadIdx.x & 63, wave = threadIdx.x >> 6, gw = blockIdx.x * NWAVES + wave, NGW = gridDim.x * NWAVES;
    for (int m = gw; m < M; m += NGW) {
        const f32x4* xr = (const f32x4*)(h + (size_t)m * D) + lane;
        f32x4 v[4];
#pragma unroll
        for (int j = 0; j < 4; ++j) v[j] = xr[64 * j];
        const float rstd = 1.0f / sqrtf(ssq[m] * (1.0f / D) + EPS);
        f32x4* o = (f32x4*)(out + (size_t)m * D) + lane;
#pragma unroll
        for (int j = 0; j < 4; ++j) { const f32x4 gg = *(const f32x4*)(g + 4 * (64 * j + lane)); o[64 * j] = v[j] * rstd * gg; }
    }
}
__device__ __forceinline__ void pool_load(const bf16* Z, int m, int lane, u32x4 (&v)[16]) {
    const int t = m % SEQ, w = 2 << (lane >> 4), cnt = (t + 1 < w) ? t + 1 : w;
#pragma unroll
    for (int s = 0; s < 16; ++s) v[s] = *(const u32x4*)(Z + (size_t)(m - (s < cnt ? s : 0)) * DZ + 8 * lane);
}
__device__ __forceinline__ void pool_finish(bf16* YC, int m, int lane, const u32x4 (&v)[16]) {
    const int t = m % SEQ, w = 2 << (lane >> 4), cnt = (t + 1 < w) ? t + 1 : w;
    float sum[8];
#pragma unroll
    for (int e = 0; e < 8; ++e) sum[e] = 0.f;
#pragma unroll
    for (int s = 0; s < 16; ++s) { const float wt = (s < cnt) ? 1.0f : 0.0f;
        sum[0] += wt * bf_lo(v[s].x); sum[1] += wt * bf_hi(v[s].x); sum[2] += wt * bf_lo(v[s].y); sum[3] += wt * bf_hi(v[s].y);
        sum[4] += wt * bf_lo(v[s].z); sum[5] += wt * bf_hi(v[s].z); sum[6] += wt * bf_lo(v[s].w); sum[7] += wt * bf_hi(v[s].w); }
    const float inv = 1.0f / (float)cnt; u32x4 o;
    o.x = cvtpk(sum[0] * inv - bf_lo(v[0].x), sum[1] * inv - bf_hi(v[0].x)); o.y = cvtpk(sum[2] * inv - bf_lo(v[0].y), sum[3] * inv - bf_hi(v[0].y));
    o.z = cvtpk(sum[4] * inv - bf_lo(v[0].z), sum[5] * inv - bf_hi(v[0].z)); o.w = cvtpk(sum[6] * inv - bf_lo(v[0].w), sum[7] * inv - bf_hi(v[0].w));
    *(u32x4*)(YC + (size_t)m * D + 8 * lane) = o;
}
__device__ __forceinline__ void pool_row(const bf16* Z, bf16* YC, int m, int lane) { u32x4 v[16]; pool_load(Z, m, lane, v); pool_finish(YC, m, lane, v); }
__device__ __forceinline__ void merge_phase(const bf16* Z, const bf16* OBR, const float* ML, bf16* YC) {
    const int lane = threadIdx.x & 63, wave = threadIdx.x >> 6, gw = blockIdx.x * NWAVES + wave, NGW = gridDim.x * NWAVES;
    const int head = lane >> 3;
    const bool contig = (M % (2 * NGW) == 0); const int rpw = M / NGW;
    for (int k_ = 0; ; ++k_) {
        const int m0 = contig ? gw * rpw + 2 * k_ : gw + 2 * k_ * NGW, mstep = contig ? 1 : NGW;
        if (m0 >= M || (contig && 2 * k_ >= rpw)) break;
        u32x4 pa[16], pb[16]; const bool pv1 = m0 + mstep < M;
        pool_load(Z, m0, lane, pa); if (pv1) pool_load(Z, m0 + mstep, lane, pb);
        f32x2_t ml[2][3]; u32x4 v[2][3];
#pragma unroll
        for (int k = 0; k < 2; ++k) { const int m = m0 + k * mstep; if (m < M) {
#pragma unroll
            for (int r = 0; r < 3; ++r) { ml[k][r] = *(const f32x2_t*)(ML + ((size_t)r * M * NH + (size_t)m * NH + head) * 2); v[k][r] = *(const u32x4*)(OBR + (size_t)r * M * DATT + (size_t)m * DATT + 8 * lane); } } }
        pool_finish(YC, m0, lane, pa); if (pv1) pool_finish(YC, m0 + mstep, lane, pb);
#pragma unroll
        for (int k = 0; k < 2; ++k) { const int m = m0 + k * mstep; if (m < M) {
            const float mx = fmaxf(fmaxf(ml[k][0].x, ml[k][1].x), ml[k][2].x);
            float wr[3], W = 0.f;
#pragma unroll
            for (int r = 0; r < 3; ++r) { wr[r] = ml[k][r].y * __builtin_amdgcn_exp2f(ml[k][r].x - mx); W += wr[r]; }
            const float iw = 1.0f / W; float acc[8];
#pragma unroll
            for (int e = 0; e < 8; ++e) acc[e] = 0.f;
#pragma unroll
            for (int r = 0; r < 3; ++r) { const u32x4 vv = v[k][r]; const float ww = wr[r] * iw;
                acc[0] += ww * bf_lo(vv.x); acc[1] += ww * bf_hi(vv.x); acc[2] += ww * bf_lo(vv.y); acc[3] += ww * bf_hi(vv.y);
                acc[4] += ww * bf_lo(vv.z); acc[5] += ww * bf_hi(vv.z); acc[6] += ww * bf_lo(vv.w); acc[7] += ww * bf_hi(vv.w); }
            u32x4 o; o.x = cvtpk(acc[0], acc[1]); o.y = cvtpk(acc[2], acc[3]); o.z = cvtpk(acc[4], acc[5]); o.w = cvtpk(acc[6], acc[7]);
            *(u32x4*)(YC + (size_t)m * D + DPOOL + 8 * lane) = o; } }
    }
}

__device__ __forceinline__ int crow(int r, int hi) { return (r & 3) + 8 * (r >> 2) + 4 * hi; }
__device__ __forceinline__ void attn_phase(const bf16* Z, bf16* OBR, float* ML, bf16* YC, LAS unsigned char* lds) {
    const int lane = threadIdx.x & 63, wave = __builtin_amdgcn_readfirstlane(threadIdx.x >> 6);
    const int q = lane & 31, hi = lane >> 5;
    LAS unsigned char* KW = lds;
    LAS unsigned char* VW = lds + 49152;
    int koff[4];
#pragma unroll
    for (int d0 = 0; d0 < 4; ++d0) koff[d0] = q * 128 + (((2 * d0 + hi) ^ (q & 7)) << 4);
    const int li = lane & 15, qp = li >> 2, pp = li & 3;
    const int swz = ((qp >> 1) & 1) << 2, chunk_l = 2 * ((lane >> 4) & 1) + (pp >> 1);
    const int ab = (4 * hi + qp) * 128 + 8 * (pp & 1) + chunk_l * 16;
    const int va0 = ab + (swz << 4), va1 = ab + ((4 ^ swz) << 4);
    const int drow = lane >> 3, dslot = lane & 7;
    const int kchunk = dslot ^ (drow & 7), vchunk = dslot ^ (((drow >> 1) & 1) << 2);
    f32x16 dqv;
#pragma unroll
    for (int rr = 0; rr < 16; ++rr) dqv[rr] = (float)(q - crow(rr, hi));
    const bool xmap = (gridDim.x == 256);
    for (int i_ = 0; ; ++i_) {
        const int item = xmap ? ((int)(blockIdx.x & 7) * 192 + 32 * i_ + (int)(blockIdx.x >> 3)) : ((int)blockIdx.x + i_ * (int)gridDim.x);
        if (item >= 3 * BATCH * NH * 32 || (xmap && i_ >= 6)) break;
        const int chunk = item & 31, h = (item >> 5) & 7, b = (item >> 8) & 1, r = item >> 9;
        const int lg = 2 * r, dil = 1 << lg, tpr = 256 >> lg, tau0 = chunk * 8, rho = tau0 >> (8 - lg), it0 = tau0 & (tpr - 1), iw0 = 32 * it0 - 128;
        const size_t rowb = (size_t)b * SEQ;
        __syncthreads();
#pragma unroll
        for (int gi = 0; gi < 6; ++gi) { const int g = wave + 8 * gi;
            if (iw0 + 8 * g >= 0) { const bf16* src = Z + (rowb + rho + (size_t)dil * (iw0 + 8 * g + drow)) * DZ + (DPOOL + DATT) + h * HD;
                __builtin_amdgcn_global_load_lds((const unsigned*)(src + kchunk * 8), (LAS unsigned*)(KW + g * 1024), 16, 0, 0);
                __builtin_amdgcn_global_load_lds((const unsigned*)(src + DATT + vchunk * 8), (LAS unsigned*)(VW + g * 1024), 16, 0, 0); } }
        const int it = it0 + wave, tq = rho + dil * (32 * it + q);
        bf16x8 qf[4];
        { const bf16* zq = Z + (rowb + tq) * DZ + DPOOL + h * HD + hi * 8;
#pragma unroll
          for (int d0 = 0; d0 < 4; ++d0) qf[d0] = *(const bf16x8*)(zq + d0 * 16); }
        const float sl2d = __builtin_amdgcn_exp2f(-(float)(h + 1)) * LOG2E * (float)dil;
        const int nt = (it < 4 ? it : 4) + 1;
        asm volatile("s_waitcnt vmcnt(0)" ::: "memory");
        __syncthreads();
        const float nsl = -sl2d;
        const f32x16 cb = dqv * nsl;
        f32x16 s[5]; float mx = -1e30f;
#pragma unroll
        for (int n = 0; n < 5; ++n) {
            if (n < nt) {
                LAS unsigned char* kb = KW + (wave + 4 - n) * 4096;
                f32x16 acc = cb + nsl * (float)(32 * n);
                if (n == 0) {
#pragma unroll
                    for (int rr = 0; rr < 16; ++rr) acc[rr] += fminf(dqv[rr], 0.f) * 1e30f; }
                if (n == 4) {
#pragma unroll
                    for (int rr = 0; rr < 16; ++rr) acc[rr] += fminf(-dqv[rr], 0.f) * 1e30f; }
#pragma unroll
                for (int d0 = 0; d0 < 4; ++d0) acc = __builtin_amdgcn_mfma_f32_32x32x16_bf16(*(const LAS bf16x8*)(kb + koff[d0]), qf[d0], acc, 0, 0, 0);
#pragma unroll
                for (int rr = 0; rr < 16; rr += 2) mx = fmaxf(fmaxf(mx, acc[rr]), acc[rr + 1]);
                s[n] = acc;
            } else {
#pragma unroll
                for (int rr = 0; rr < 16; ++rr) s[n][rr] = -1e30f;
            }
        }
        mx = fmaxf(mx, __shfl_xor(mx, 32));
        u32x4 pw[5][2];
#pragma unroll
        for (int n = 0; n < 5; ++n) {
            const f32x16 t = s[n] - mx;
#pragma unroll
            for (int rr = 0; rr < 16; ++rr) s[n][rr] = __builtin_amdgcn_exp2f(t[rr]);
            pw[n][0].x = cvtpk(s[n][0], s[n][1]); pw[n][0].y = cvtpk(s[n][2], s[n][3]); pw[n][0].z = cvtpk(s[n][4], s[n][5]); pw[n][0].w = cvtpk(s[n][6], s[n][7]);
            pw[n][1].x = cvtpk(s[n][8], s[n][9]); pw[n][1].y = cvtpk(s[n][10], s[n][11]); pw[n][1].z = cvtpk(s[n][12], s[n][13]); pw[n][1].w = cvtpk(s[n][14], s[n][15]);
        }
        float lsum;
        { const f32x16 ps = ((s[0] + s[1]) + (s[2] + s[3])) + s[4];
          lsum = (((ps[0] + ps[1]) + (ps[2] + ps[3])) + ((ps[4] + ps[5]) + (ps[6] + ps[7]))) + (((ps[8] + ps[9]) + (ps[10] + ps[11])) + ((ps[12] + ps[13]) + (ps[14] + ps[15]))); }
        f32x16 o0, o1;
#pragma unroll
        for (int rr = 0; rr < 16; ++rr) { o0[rr] = 0.f; o1[rr] = 0.f; }
#define VTR(off_) __builtin_bit_cast(s16x4, __builtin_amdgcn_ds_read_tr16_b64_v4i16((LAS s16x4*)(vb + (off_))))
#define MKA(lo_, hi_) (bf16x8){lo_[0], lo_[1], lo_[2], lo_[3], hi_[0], hi_[1], hi_[2], hi_[3]}
#pragma unroll
        for (int n = 0; n < 5; ++n) {
            if (n < nt) {
                LAS unsigned char* vb = VW + (wave + 4 - n) * 4096;
                const bf16x8 p0 = __builtin_bit_cast(bf16x8, pw[n][0]), p1 = __builtin_bit_cast(bf16x8, pw[n][1]);
                const s16x4 l0 = VTR(va0), h0 = VTR(va0 + 8 * 128), l1 = VTR(va0 + 16 * 128), h1 = VTR(va0 + 24 * 128);
                const s16x4 l2 = VTR(va1), h2 = VTR(va1 + 8 * 128), l3 = VTR(va1 + 16 * 128), h3 = VTR(va1 + 24 * 128);
                o0 = __builtin_amdgcn_mfma_f32_32x32x16_bf16(MKA(l0, h0), p0, o0, 0, 0, 0);
                o0 = __builtin_amdgcn_mfma_f32_32x32x16_bf16(MKA(l1, h1), p1, o0, 0, 0, 0);
                o1 = __builtin_amdgcn_mfma_f32_32x32x16_bf16(MKA(l2, h2), p0, o1, 0, 0, 0);
                o1 = __builtin_amdgcn_mfma_f32_32x32x16_bf16(MKA(l3, h3), p1, o1, 0, 0, 0);
            }
        }
#undef VTR
#undef MKA
        const float l_tot = lsum + __shfl_xor(lsum, 32), inv = 1.0f / l_tot;
        bf16* orow = OBR + (size_t)r * M * DATT + (rowb + tq) * DATT + h * HD + 4 * hi;
#pragma unroll
        for (int rg = 0; rg < 4; ++rg) {
            u32x2 w0, w1;
            w0.x = cvtpk(o0[4 * rg] * inv, o0[4 * rg + 1] * inv); w0.y = cvtpk(o0[4 * rg + 2] * inv, o0[4 * rg + 3] * inv);
            w1.x = cvtpk(o1[4 * rg] * inv, o1[4 * rg + 1] * inv); w1.y = cvtpk(o1[4 * rg + 2] * inv, o1[4 * rg + 3] * inv);
            *(u32x2*)(orow + 8 * rg) = w0; *(u32x2*)(orow + 32 + 8 * rg) = w1; }
        if (hi == 0) { f32x2_t ml = {mx, l_tot}; *(f32x2_t*)(ML + (size_t)r * M * NH * 2 + ((rowb + tq) * NH + h) * 2) = ml; }
    }
    __syncthreads();
}

#define XB_TMO      128
#define XB_XCNT(j)  (256  + 64 * (j))
#define XB_XSUB(j)  (1280 + 64 * (j))
#define XB_XGEN(j)  (2304 + 64 * (j))
#define XB_TOP      3328
#define XB_TOPGEN   3392
#define XCD_BAR_WORDS 3456
#define XB_SPIN_CAP (1u << 18)

__device__ __forceinline__ unsigned xb_ld(unsigned* p)              { return __hip_atomic_load(p, __ATOMIC_RELAXED, __HIP_MEMORY_SCOPE_AGENT); }
__device__ __forceinline__ unsigned xb_add(unsigned* p, unsigned v) { return __hip_atomic_fetch_add(p, v, __ATOMIC_RELAXED, __HIP_MEMORY_SCOPE_AGENT); }
__device__ __forceinline__ unsigned xb_xcc_id() { return (unsigned)__builtin_amdgcn_s_getreg((3 << 11) | 20) & 0xFu; }
#define XB_SPIN(cond, bar) do { unsigned _sp = 0; while (cond) { __builtin_amdgcn_s_sleep(1); \
    if ((++_sp & 255u) == 0u) { if (xb_ld(&(bar)[XB_TMO])) break; if (_sp > XB_SPIN_CAP) { atomicAdd(&(bar)[XB_TMO], 1u); break; } } } } while (0)

struct XcdBarrier {
    unsigned* bar; unsigned x;
    volatile LAS unsigned* st;
};

__device__ __forceinline__ XcdBarrier xcd_barrier_post(unsigned* bar, volatile LAS unsigned* st) {
    XcdBarrier b; b.bar = bar; b.x = xb_xcc_id(); b.st = st;
    if (threadIdx.x == 0) (void)xb_add(&bar[XB_XCNT(b.x)], 1u);
    return b;
}
__device__ __forceinline__ void xcd_barrier_complete(unsigned* bar, unsigned x, unsigned& nloc, unsigned& nx) {
    const unsigned G = gridDim.x * gridDim.y * gridDim.z;
    unsigned sum, cnt, mine, sp = 0u;
    for (;;) {
        sum = 0u; cnt = 0u; mine = 0u;
#pragma unroll
        for (unsigned j = 0; j < 16; ++j) { const unsigned c = xb_ld(&bar[XB_XCNT(j)]); sum += c; cnt += (c > 0u) ? 1u : 0u; mine = (j == x) ? c : mine; }
        if (sum == G) break;
        __builtin_amdgcn_s_sleep(1);
        if ((++sp & 255u) == 0u) { if (xb_ld(&bar[XB_TMO])) break; if (sp > XB_SPIN_CAP) { atomicAdd(&bar[XB_TMO], 1u); break; } }
    }
    nloc = mine > 0u ? mine : 1u; nx = cnt > 0u ? cnt : 1u;
}

__device__ __forceinline__ void xcd_barrier(const XcdBarrier& b) {
    asm volatile("s_waitcnt vmcnt(0)" ::: "memory");
    __syncthreads();
    if (threadIdx.x == 0) {
        unsigned* bar = b.bar;
        __builtin_amdgcn_s_waitcnt(0);
        unsigned nloc = b.st[0], nx = b.st[1];
        if (nloc == 0u) { xcd_barrier_complete(bar, b.x, nloc, nx); b.st[0] = nloc; b.st[1] = nx; }
        const unsigned old = xb_add(&bar[XB_XSUB(b.x)], 1u);
        const unsigned gen = old / nloc;
        if (old + 1u == (gen + 1u) * nloc) {
            __builtin_amdgcn_fence(__ATOMIC_RELEASE, "agent");
            asm volatile("s_waitcnt vmcnt(0)" ::: "memory");
            const unsigned og = xb_add(&bar[XB_TOP], 1u);
            const unsigned tg = og / nx;
            if (og + 1u == (tg + 1u) * nx) xb_add(&bar[XB_TOPGEN], 1u);
            else XB_SPIN(xb_ld(&bar[XB_TOPGEN]) == tg, bar);
            __builtin_amdgcn_fence(__ATOMIC_ACQUIRE, "agent");
            xb_add(&bar[XB_XGEN(b.x)], 1u);
            asm volatile("s_waitcnt vmcnt(0)" ::: "memory");
        } else {
            XB_SPIN(xb_ld(&bar[XB_XGEN(b.x)]) == gen, bar);
            __builtin_amdgcn_fence(__ATOMIC_ACQUIRE, "agent");
            asm volatile("s_waitcnt vmcnt(0)" ::: "memory");
        }
    }
    __syncthreads();
}

constexpr int LDS_BYTES = 147456;
struct Args { const float* in[18]; float* out; unsigned char* ws; int ph_lo, ph_hi; };
enum { PH_PRO = 0, PH_N1, PH_GU1, PH_DN1, PH_ZIN, PH_ATT, PH_MRG, PH_WOUT, PH_GU2, PH_DN2, PH_COUNT };

__global__ void __launch_bounds__(NTHREADS, 2) fwd_megakernel(Args a) {
    extern __shared__ __attribute__((aligned(16))) unsigned char lds_raw[];
    LAS unsigned char* lds = (LAS unsigned char*)lds_raw;
    cg::grid_group grid = cg::this_grid();
    unsigned char* ws = a.ws;
    const float *x = a.in[0], *c = a.in[1], *w_ada = a.in[2], *b_ada = a.in[3], *g_ffn1 = a.in[4], *g_mix = a.in[8], *g_ffn2 = a.in[13], *g_final = a.in[17];
    float* mod = (float*)(ws + WS_MOD);
    bf16 *W1GU = (bf16*)(ws + WS_W1GU), *W1D = (bf16*)(ws + WS_W1D), *WIN = (bf16*)(ws + WS_WIN), *WOUT = (bf16*)(ws + WS_WOUT), *W2GU = (bf16*)(ws + WS_W2GU), *W2D = (bf16*)(ws + WS_W2D);
    bf16 *XN = (bf16*)(ws + WS_XN), *HID = (bf16*)(ws + WS_HID), *Z = (bf16*)(ws + WS_Z), *OBR = (bf16*)(ws + WS_OBR), *YC = (bf16*)(ws + WS_YC);
    float* ML = (float*)(ws + WS_ML);
    float* SSQ = (float*)(ws + WS_SSQ);
    float *BIAS1 = (float*)(ws + WS_BIAS), *BIASZ = BIAS1 + 2 * 2 * DFF * 2 / 2, *BIAS2 = BIASZ + 2 * DZ;
    bf16* HB = (bf16*)(ws + WS_HB);
    const int G = gridDim.x, bx = blockIdx.x;
    const int lo = a.ph_lo, hi = a.ph_hi;
    volatile LAS unsigned* MISC = (volatile LAS unsigned*)(lds + 131072);
    if (threadIdx.x < 64) MISC[threadIdx.x] = 0u;
    __syncthreads();
    XcdBarrier bar = xcd_barrier_post((unsigned*)(ws + WS_BAR), MISC + 8);
    const WPtrs WP{a.in[5], a.in[6], a.in[7], a.in[9], a.in[10], a.in[11], a.in[12], a.in[14], a.in[15], a.in[16], W1GU, W1D, WIN, WOUT, W2GU, W2D};
    const bool defer_late = (G == 256) && (lo == 0) && (hi == PH_COUNT);
#define IN(k) (lo <= (k) && (k) < hi)
#define GSYNC() do { __syncthreads(); grid.sync(); } while (0)
#define XSYNC() xcd_barrier(bar)
#define SEAM(k) do { if (IN(k) && IN((k) + 1)) XSYNC(); } while (0)
    if (lo > hi) GSYNC();
#ifndef DUP_MASK
#define DUP_MASK 0
#endif
#ifndef EXTRA_SYNCS
#define EXTRA_SYNCS 0
#endif
#define RUNPH(k, BODY) do { if (IN(k)) { BODY; if ((DUP_MASK >> (k)) & 1) { XSYNC(); BODY; } } SEAM(k); } while (0)
#define BODY_PRO { ada_phase(c, w_ada, b_ada, mod, lds); \
        for (int i = bx * NTHREADS + threadIdx.x; i < 3 * M; i += G * NTHREADS) SSQ[M + i] = 0.f; \
        for (int i = bx * NTHREADS + threadIdx.x; i < 64 * 64; i += G * NTHREADS) ((unsigned*)(ws + WS_CNT))[i] = 0u; \
        weights_early(WP, lds); if (!defer_late) weights_late(WP, 0, lds); }
#define BODY_N1 { prep_rows_phase(x, g_ffn1, mod + 1 * D, XN, SSQ); \
        const int gw_ = bx * NWAVES + (threadIdx.x >> 6), NGW_ = G * NWAVES, ln_ = threadIdx.x & 63; \
        bias_rows(W1GU, 2 * DFF, mod + 0 * D, BIAS1, gw_, NGW_, ln_); }
#define BODY_GU(WGU, SSQ_, BIAS_) { pg8::Gemm g{XN, WGU, M, 2 * DFF, D}; pg8::StaticOrder S; S.init(M, 2 * DFF, G, bx); pg8::EpiSwiGLU E{HID, DFF, SSQ_, BIAS_, 2 * DFF, SEQ}; \
        pg8::gemm_phase<pg8::EpiSwiGLU, pg8::StaticOrder, true, true>(lds, g, S, E); }
#define BODY_RES(NEXT_, RESBF_, A_, W_, K_, RES_, MIDX, F_, SSQO_, GN_, SCN_) { pg8::Gemm g{A_, W_, M, D, K_}; pg8::StaticOrder S; S.init(M, D, G, bx); \
        pg8::EpiResid<NEXT_, RESBF_, true> E{RES_, HB, mod + (MIDX) * D, NMOD * D, F_, D, SEQ, SSQO_, XN, GN_, SCN_}; \
        pg8::gemm_phase<pg8::EpiResid<NEXT_, RESBF_, true>, pg8::StaticOrder, true, true>(lds, g, S, E); }
#define BODY_ZIN { pg8::Gemm g{XN, WIN, M, DZ, D}; pg8::StaticOrder S; S.init(M, DZ, G, bx); pg8::EpiZ E{Z, DZ, 2, 4, QSCALE, SSQ + M, BIASZ, DZ, SEQ}; \
        pg8::gemm_phase<pg8::EpiZ, pg8::StaticOrder, true, true>(lds, g, S, E); }
    RUNPH(PH_PRO, BODY_PRO);
    for (int i = 0; i < EXTRA_SYNCS; ++i) XSYNC();
    RUNPH(PH_N1, BODY_N1);
    RUNPH(PH_GU1, { BODY_GU(W1GU, SSQ, BIAS1); if (defer_late) weights_late(WP, 128, lds); });
#if defined(PROBE_DN1)
    if (IN(PH_DN1)) { BODY_RES(true, false, HID, W1D, DFF, x, 2, 0.5f, (float*)(ws + WS_YC), g_mix, mod + 4 * D); XSYNC(); }
#endif
#define BODY_BIASZ { const int gw_ = bx * NWAVES + (threadIdx.x >> 6), NGW_ = G * NWAVES, ln_ = threadIdx.x & 63; bias_rows(WIN, DZ, mod + 3 * D, BIASZ, gw_, NGW_, ln_); }
#define BODY_BIAS2 { const int gw_ = bx * NWAVES + (threadIdx.x >> 6), NGW_ = G * NWAVES, ln_ = threadIdx.x & 63; bias_rows(W2GU, 2 * DFF, mod + 6 * D, BIAS2, gw_, NGW_, ln_); }
    RUNPH(PH_DN1, { BODY_BIASZ; BODY_RES(true, false, HID, W1D, DFF, x, 2, 0.5f, SSQ + M, g_mix, mod + 4 * D); });
    RUNPH(PH_ZIN, BODY_ZIN);
    RUNPH(PH_ATT, { BODY_BIAS2; attn_phase(Z, OBR, ML, YC, lds); });
    RUNPH(PH_MRG, merge_phase(Z, OBR, ML, YC));
    RUNPH(PH_WOUT, BODY_RES(true, true, YC, WOUT, D, HB, 5, 1.0f, SSQ + 2 * M, g_ffn2, mod + 7 * D));
    RUNPH(PH_GU2, BODY_GU(W2GU, SSQ + 2 * M, BIAS2));
#define BODY_DN2 { pg8::Gemm g{HID, W2D, M, D, DFF}; pg8::StaticOrder S; S.init(M, D, G, bx); \
        if (G == 256) { pg8::EpiResidFinal E{HB, a.out, mod + 8 * D, NMOD * D, 0.5f, D, SEQ, SSQ + 3 * M, (unsigned*)(ws + WS_CNT), g_final, 32u}; \
            pg8::gemm_phase<pg8::EpiResidFinal, pg8::StaticOrder, true, true>(lds, g, S, E); } \
        else {     \
            pg8::EpiResid<false, true, false> E{HB, a.out, mod + 8 * D, NMOD * D, 0.5f, D, SEQ, SSQ + 3 * M, XN, g_final, mod}; \
            pg8::gemm_phase<pg8::EpiResid<false, true, false>, pg8::StaticOrder, true, true>(lds, g, S, E); \
            XSYNC(); final_norm_phase(a.out, g_final, SSQ + 3 * M, a.out); } }
    RUNPH(PH_DN2, BODY_DN2);
#undef IN
}

#ifndef MK_COOP
#define MK_COOP 1
#endif
extern "C" void kernel_launch(void* const* d_in, const int* in_sizes, int n_in, void* d_out, int out_size, void* d_ws, size_t ws_size, hipStream_t stream) {
    static int grid = 0;
    if (grid == 0) {
        if (n_in != 18 || in_sizes[0] != M * D || out_size != M * D || ws_size < WS_END) { fprintf(stderr, "kernel_launch: unexpected shapes (n_in %d, in0 %d, out %d, ws %zu)\n", n_in, n_in > 0 ? in_sizes[0] : -1, out_size, ws_size); grid = -1; return; }
        int dev = 0, cus = 0, per_cu = 0;
        if (hipGetDevice(&dev) != hipSuccess || hipDeviceGetAttribute(&cus, hipDeviceAttributeMultiprocessorCount, dev) != hipSuccess) { grid = -1; return; }
        if (hipFuncSetAttribute((const void*)fwd_megakernel, hipFuncAttributeMaxDynamicSharedMemorySize, LDS_BYTES) != hipSuccess) { fprintf(stderr, "kernel_launch: hipFuncSetAttribute failed\n"); grid = -1; return; }
        if (hipOccupancyMaxActiveBlocksPerMultiprocessor(&per_cu, (const void*)fwd_megakernel, NTHREADS, LDS_BYTES) != hipSuccess || per_cu < 1) { fprintf(stderr, "kernel_launch: occupancy query says %d\n", per_cu); per_cu = 1; }
        (void)hipGetLastError();
        grid = cus * 1;
        if (grid > cus * per_cu) grid = cus * per_cu;
    }
    if (grid < 0) return;
    if (hipMemsetAsync((char*)d_ws + WS_MOD, 0, WS_BAR + WS_BAR_BYTES - WS_MOD, stream) != hipSuccess) { fprintf(stderr, "kernel_launch: memset failed\n"); return; }
    Args a{};
    for (int i = 0; i < 18; ++i) a.in[i] = (const float*)d_in[i];
    a.out = (float*)d_out; a.ws = (unsigned char*)d_ws;
#if MK_COOP
    a.ph_lo = 0; a.ph_hi = PH_COUNT;
    void* args[] = {&a};
    hipError_t e = hipLaunchCooperativeKernel((const void*)fwd_megakernel, dim3(grid), dim3(NTHREADS), args, LDS_BYTES, stream);
    if (e != hipSuccess) fprintf(stderr, "cooperative launch failed: %s (grid %d)\n", hipGetErrorString(e), grid);
#else
    for (int ph = 0; ph < PH_COUNT; ++ph) { a.ph_lo = ph; a.ph_hi = ph + 1; hipLaunchKernelGGL(fwd_megakernel, dim3(grid), dim3(NTHREADS), LDS_BYTES, stream, a); }
#endif
}
```

```cpp
#include <hip/hip_runtime.h>
#include <hip/hip_cooperative_groups.h>
#include <cstdio>
#include <cstdint>
namespace cg = cooperative_groups;
namespace pg8 {
#define PG8_LAS __attribute__((address_space(3)))
typedef unsigned short bf16_t;
typedef short bf16x8 __attribute__((ext_vector_type(8)));
typedef float f32x4 __attribute__((ext_vector_type(4)));
typedef unsigned u32x4 __attribute__((ext_vector_type(4)));
constexpr int BM = 256, BK = 64, HALF = 128, HTB = HALF * BK * 2  , STAGE_BYTES = 8 * HTB, NXCD = 8, WGM = 4;

__host__ __device__ __forceinline__ int lds_byte(int r, int c) { const int st = (r >> 4) * 2 + (c >> 5), rr = r & 15, cc = c & 31, ob = rr * 64 + cc * 2; return st * 1024 + (ob ^ (((ob >> 9) & 1) << 5)); }
__host__ __device__ __forceinline__ void stage_rc(int b, int& R, int& C) { const int st = b / 1024, sb = b % 1024, swz = sb ^ (((sb >> 9) & 1) << 5); R = (st >> 1) * 16 + swz / 64; C = (st & 1) * 32 + (swz % 64) / 2; }
__host__ __device__ __forceinline__ int perm32(int rho) { const int n = rho >> 4, i = rho & 15; return 8 * (i >> 2) + 4 * n + (i & 3); }

struct Unit { int pm, pn; };
struct Gemm { const bf16_t* A; const bf16_t* Bt; int M, N, K; };

struct StaticOrder {
    int nM, nN, nwg, G, c;
    __host__ __device__ void init(int M, int N, int G_, int c_) { nM = M / BM; nN = N / BM; nwg = nM * nN; G = G_; c = c_; }
    __host__ __device__ bool next(int i, Unit& u) const {
        const long L = (long)i * G + c; if (L >= nwg) return false;
        int wgid = (int)L; { const int q = nwg / NXCD, r = nwg % NXCD, xcd = wgid % NXCD, off = wgid / NXCD; wgid = (xcd < r ? xcd * (q + 1) : r * (q + 1) + (xcd - r) * q) + off; }
        const int nig = WGM * nN, gid = wgid / nig, fm = gid * WGM, gsz = (nM - fm) < WGM ? (nM - fm) : WGM;
        u.pm = fm + ((wgid % nig) % gsz); u.pn = (wgid % nig) / gsz; return true;
    }
    __device__ __forceinline__ void a_ready(const Unit&) const {}
    __device__ __forceinline__ void done(const Unit&) const {}
};


__device__ __forceinline__ unsigned cvt_pk_bf16(float lo, float hi) { unsigned r; asm volatile("v_cvt_pk_bf16_f32 %0, %1, %2" : "=v"(r) : "v"(lo), "v"(hi)); return r; }
typedef float f32x2v __attribute__((ext_vector_type(2)));
__device__ __forceinline__ f32x2v swiglu2(f32x2v g, f32x2v u) { const f32x2v t = g * (-1.4426950408889634f); f32x2v e; e.x = __builtin_amdgcn_exp2f(t.x); e.y = __builtin_amdgcn_exp2f(t.y);
    const f32x2v d = e + 1.0f; f32x2v r; r.x = __builtin_amdgcn_rcpf(d.x); r.y = __builtin_amdgcn_rcpf(d.y); return (g * u) * r; }
__device__ __forceinline__ float silu_f(float g) { return g * __builtin_amdgcn_rcpf(1.0f + __builtin_amdgcn_exp2f(-1.4426950408889634f * g)); }

__device__ __forceinline__ float rstd_of(const float* ssq, int row) { return __builtin_amdgcn_rsqf(ssq[row] * (1.0f / 1024.0f) + 1e-6f); }
struct EpiSwiGLU {
    static constexpr bool PERM = true, AFTER_DRAIN = false;
    bf16_t* O; int ldc; const float* ssq; const float* bias; int bias_bstride; int rows_per_batch;
    __device__ __forceinline__ void operator()(const f32x4 (&acc)[2][2][4][2], const Unit& u, int wr, int wc, int fr, int fq) const {
        const int row0 = u.pm * BM + wr * 64 + fr, col0 = u.pn * HALF + wc * 32 + 8 * fq;
        const float* bp = bias + (size_t)((u.pm * BM) / rows_per_batch) * bias_bstride + u.pn * BM + wc * 32 + 8 * fq;
        const f32x4 bg0 = *(const f32x4*)(bp), bg1 = *(const f32x4*)(bp + 4), bu0 = *(const f32x4*)(bp + HALF), bu1 = *(const f32x4*)(bp + HALF + 4);
        float rsv[2][4];
#pragma unroll
        for (int ai = 0; ai < 2; ++ai)
#pragma unroll
            for (int m = 0; m < 4; ++m) rsv[ai][m] = rstd_of(ssq, row0 + ai * HALF + m * 16);
#pragma unroll
        for (int ai = 0; ai < 2; ++ai)
#pragma unroll
            for (int m = 0; m < 4; ++m) { const int row = row0 + ai * HALF + m * 16; bf16_t* rowp = O + (size_t)row * ldc + col0; const float rs = rsv[ai][m];
                const f32x4 g0 = acc[ai][0][m][0] * rs + bg0, g1 = acc[ai][0][m][1] * rs + bg1, u0 = acc[ai][1][m][0] * rs + bu0, u1 = acc[ai][1][m][1] * rs + bu1;
                u32x4 w;
                { const f32x2v a = swiglu2((f32x2v){g0[0], g0[1]}, (f32x2v){u0[0], u0[1]}), b = swiglu2((f32x2v){g0[2], g0[3]}, (f32x2v){u0[2], u0[3]});
                  const f32x2v c = swiglu2((f32x2v){g1[0], g1[1]}, (f32x2v){u1[0], u1[1]}), d = swiglu2((f32x2v){g1[2], g1[3]}, (f32x2v){u1[2], u1[3]});
                  w.x = cvt_pk_bf16(a.x, a.y); w.y = cvt_pk_bf16(b.x, b.y); w.z = cvt_pk_bf16(c.x, c.y); w.w = cvt_pk_bf16(d.x, d.y); }
                *(u32x4*)rowp = w; }
    }
};
struct EpiZ {
    static constexpr bool PERM = true, AFTER_DRAIN = false;
    bf16_t* O; int ldc; int sc_lo, sc_hi; float scale; const float* ssq; const float* bias; int bias_bstride; int rows_per_batch;
    __device__ __forceinline__ void operator()(const f32x4 (&acc)[2][2][4][2], const Unit& u, int wr, int wc, int fr, int fq) const {
        const int row0 = u.pm * BM + wr * 64 + fr, col0 = u.pn * BM + wc * 32 + 8 * fq;
        const float sc = (u.pn >= sc_lo && u.pn < sc_hi) ? scale : 1.0f;
        const float* bp = bias + (size_t)((u.pm * BM) / rows_per_batch) * bias_bstride + col0;
        f32x4 bv[2][2];
#pragma unroll
        for (int bj = 0; bj < 2; ++bj) { bv[bj][0] = *(const f32x4*)(bp + bj * HALF) * sc; bv[bj][1] = *(const f32x4*)(bp + bj * HALF + 4) * sc; }
        float rsv[2][4];
#pragma unroll
        for (int ai = 0; ai < 2; ++ai)
#pragma unroll
            for (int m = 0; m < 4; ++m) rsv[ai][m] = rstd_of(ssq, row0 + ai * HALF + m * 16) * sc;
#pragma unroll
        for (int ai = 0; ai < 2; ++ai)
#pragma unroll
            for (int m = 0; m < 4; ++m) { const int row = row0 + ai * HALF + m * 16; bf16_t* rowp = O + (size_t)row * ldc + col0; const float rs = rsv[ai][m];
#pragma unroll
                for (int bj = 0; bj < 2; ++bj) { const f32x4 v0 = acc[ai][bj][m][0] * rs + bv[bj][0], v1 = acc[ai][bj][m][1] * rs + bv[bj][1];
                    u32x4 w; w.x = cvt_pk_bf16(v0[0], v0[1]); w.y = cvt_pk_bf16(v0[2], v0[3]); w.z = cvt_pk_bf16(v1[0], v1[1]); w.w = cvt_pk_bf16(v1[2], v1[3]);
                    *(u32x4*)(rowp + bj * HALF) = w; } }
    }
};
template <bool BF> __device__ __forceinline__ void load_res8(const void* p, size_t off, f32x4& a, f32x4& b) {
    if (BF) { const u32x4 w = *(const u32x4*)((const bf16_t*)p + off);
        a = (f32x4){__builtin_bit_cast(float, w.x << 16), __builtin_bit_cast(float, w.x & 0xffff0000u), __builtin_bit_cast(float, w.y << 16), __builtin_bit_cast(float, w.y & 0xffff0000u)};
        b = (f32x4){__builtin_bit_cast(float, w.z << 16), __builtin_bit_cast(float, w.z & 0xffff0000u), __builtin_bit_cast(float, w.w << 16), __builtin_bit_cast(float, w.w & 0xffff0000u)}; }
    else { a = *(const f32x4*)((const float*)p + off); b = *(const f32x4*)((const float*)p + off + 4); }
}
struct EpiResidFinal {
    static constexpr bool PERM = true, AFTER_DRAIN = false;
    const bf16_t* res; float* out; const float* coef; int mod_bstride; float f; int ldc; int rows_per_batch; float* ssq; unsigned* cnt; const float* g; unsigned want;
    __device__ __forceinline__ void operator()(const f32x4 (&acc)[2][2][4][2], const Unit& u, int wr, int wc, int fr, int fq) const {
        const int row0 = u.pm * BM + wr * 64 + fr, col0 = u.pn * BM + wc * 32 + 8 * fq;
        const size_t boff = (size_t)((u.pm * BM) / rows_per_batch) * mod_bstride;
        f32x4 cv[2][2]; float fl = f; asm volatile("" : "+v"(fl));
#pragma unroll
        for (int bj = 0; bj < 2; ++bj)
#pragma unroll
            for (int n = 0; n < 2; ++n) cv[bj][n] = *(const f32x4*)(coef + boff + col0 + bj * HALF + n * 4) * fl;
        f32x4 h[2][4][2][2];
#pragma unroll
        for (int ai = 0; ai < 2; ++ai)
#pragma unroll
            for (int m = 0; m < 4; ++m) { const int row = row0 + ai * HALF + m * 16; const size_t off = (size_t)row * ldc + col0; float ss = 0.f;
#pragma unroll
                for (int bj = 0; bj < 2; ++bj) { f32x4 rr[2]; load_res8<true>(res, off + bj * HALF, rr[0], rr[1]);
#pragma unroll
                    for (int n = 0; n < 2; ++n) { const f32x4 hv = rr[n] + cv[bj][n] * acc[ai][bj][m][n]; h[ai][m][bj][n] = hv;
                        ss += (hv[0] * hv[0] + hv[1] * hv[1]) + (hv[2] * hv[2] + hv[3] * hv[3]); } }
                ss += __shfl_xor(ss, 16); ss += __shfl_xor(ss, 32);
                if (fq == 0) atomicAdd(ssq + row, ss); }
        asm volatile("s_waitcnt vmcnt(0)" ::: "memory");
        unsigned* cw = cnt + 64 * u.pm;
        if ((threadIdx.x & 63) == 0) __hip_atomic_fetch_add(cw, 1u, __ATOMIC_RELAXED, __HIP_MEMORY_SCOPE_AGENT);
        { unsigned sp = 0; while (__hip_atomic_load(cw, __ATOMIC_RELAXED, __HIP_MEMORY_SCOPE_AGENT) < want) { __builtin_amdgcn_s_sleep(2); if (++sp > (1u << 20)) break; } }
        asm volatile("" ::: "memory");
        f32x4 gv[2][2];
#pragma unroll
        for (int bj = 0; bj < 2; ++bj)
#pragma unroll
            for (int n = 0; n < 2; ++n) gv[bj][n] = *(const f32x4*)(g + col0 + bj * HALF + n * 4);
        float rsv[2][4];
#pragma unroll
        for (int ai = 0; ai < 2; ++ai)
#pragma unroll
            for (int m = 0; m < 4; ++m) { const float sq = __hip_atomic_load(ssq + row0 + ai * HALF + m * 16, __ATOMIC_RELAXED, __HIP_MEMORY_SCOPE_AGENT); rsv[ai][m] = __builtin_amdgcn_rsqf(sq * (1.0f / 1024.0f) + 1e-6f); }
#pragma unroll
        for (int ai = 0; ai < 2; ++ai)
#pragma unroll
            for (int m = 0; m < 4; ++m) { const int row = row0 + ai * HALF + m * 16; const size_t off = (size_t)row * ldc + col0;
                const float rs = rsv[ai][m];
#pragma unroll
                for (int bj = 0; bj < 2; ++bj)
#pragma unroll
                    for (int n = 0; n < 2; ++n) *(f32x4*)(out + off + bj * HALF + n * 4) = h[ai][m][bj][n] * rs * gv[bj][n]; }
    }
};
template <bool NEXT, bool RES_BF, bool OUT_BF> struct EpiResid {
    static constexpr bool PERM = true, AFTER_DRAIN = false;
    const void* res; void* out; const float* coef; int mod_bstride; float f; int ldc; int rows_per_batch; float* ssq_out; bf16_t* an; const float* g_next; const float* scale_next;
    __device__ __forceinline__ void operator()(const f32x4 (&acc)[2][2][4][2], const Unit& u, int wr, int wc, int fr, int fq) const {
        const int row0 = u.pm * BM + wr * 64 + fr, col0 = u.pn * BM + wc * 32 + 8 * fq;
        const size_t boff = (size_t)((u.pm * BM) / rows_per_batch) * mod_bstride;
        f32x4 cv[2][2], gm[2][2]; float fl = f; asm volatile("" : "+v"(fl));
#pragma unroll
        for (int bj = 0; bj < 2; ++bj)
#pragma unroll
            for (int n = 0; n < 2; ++n) { cv[bj][n] = *(const f32x4*)(coef + boff + col0 + bj * HALF + n * 4) * fl;
                if (NEXT) gm[bj][n] = *(const f32x4*)(g_next + col0 + bj * HALF + n * 4) * (*(const f32x4*)(scale_next + boff + col0 + bj * HALF + n * 4) + 1.0f); }
        constexpr int MB = RES_BF ? 4 : 2;
#pragma unroll
        for (int ai = 0; ai < 2; ++ai)
#pragma unroll
            for (int mb = 0; mb < 4; mb += MB) {
                u32x4 rb[MB][2]; f32x4 rf[MB][2][2];
#pragma unroll
                for (int mi = 0; mi < MB; ++mi)
#pragma unroll
                    for (int bj = 0; bj < 2; ++bj) { const size_t off = (size_t)(row0 + ai * HALF + (mb + mi) * 16) * ldc + col0 + bj * HALF;
                        if (RES_BF) rb[mi][bj] = *(const u32x4*)((const bf16_t*)res + off);
                        else { rf[mi][bj][0] = *(const f32x4*)((const float*)res + off); rf[mi][bj][1] = *(const f32x4*)((const float*)res + off + 4); } }
#pragma unroll
                for (int mi = 0; mi < MB; ++mi) { const int m = mb + mi; const int row = row0 + ai * HALF + m * 16; const size_t off = (size_t)row * ldc + col0; float ss = 0.f;
#pragma unroll
                    for (int bj = 0; bj < 2; ++bj) { f32x4 h[2];
                        if (RES_BF) { const u32x4 w = rb[mi][bj];
                            h[0] = (f32x4){__builtin_bit_cast(float, w.x << 16), __builtin_bit_cast(float, w.x & 0xffff0000u), __builtin_bit_cast(float, w.y << 16), __builtin_bit_cast(float, w.y & 0xffff0000u)};
                            h[1] = (f32x4){__builtin_bit_cast(float, w.z << 16), __builtin_bit_cast(float, w.z & 0xffff0000u), __builtin_bit_cast(float, w.w << 16), __builtin_bit_cast(float, w.w & 0xffff0000u)}; }
                        else { h[0] = rf[mi][bj][0]; h[1] = rf[mi][bj][1]; }
#pragma unroll
                        for (int n = 0; n < 2; ++n) { h[n] = h[n] + cv[bj][n] * acc[ai][bj][m][n]; ss += (h[n][0] * h[n][0] + h[n][1] * h[n][1]) + (h[n][2] * h[n][2] + h[n][3] * h[n][3]); }
                        if (OUT_BF) { u32x4 w; w.x = cvt_pk_bf16(h[0][0], h[0][1]); w.y = cvt_pk_bf16(h[0][2], h[0][3]); w.z = cvt_pk_bf16(h[1][0], h[1][1]); w.w = cvt_pk_bf16(h[1][2], h[1][3]);
                            *(u32x4*)((bf16_t*)out + off + bj * HALF) = w; }
                        else { *(f32x4*)((float*)out + off + bj * HALF) = h[0]; *(f32x4*)((float*)out + off + bj * HALF + 4) = h[1]; }
                        if (NEXT) { const f32x4 a0 = h[0] * gm[bj][0], a1 = h[1] * gm[bj][1];
                            u32x4 w; w.x = cvt_pk_bf16(a0[0], a0[1]); w.y = cvt_pk_bf16(a0[2], a0[3]); w.z = cvt_pk_bf16(a1[0], a1[1]); w.w = cvt_pk_bf16(a1[2], a1[3]);
                            *(u32x4*)(an + off + bj * HALF) = w; } }
                    ss += __shfl_xor(ss, 16); ss += __shfl_xor(ss, 32);
                    if (fq == 0) atomicAdd(ssq_out + row, ss); }
            }
    }
};

template <class Epi, class Sched, bool ALIGN_EPI = false, bool SP2 = false>
__device__ __forceinline__ void gemm_phase(PG8_LAS unsigned char* lds, const Gemm g, const Sched& S, const Epi& E) {
    const int tid = threadIdx.x, wid = __builtin_amdgcn_readfirstlane(tid >> 6), lane = tid & 63, wr = wid >> 2, wc = wid & 3, fr = lane & 15, fq = lane >> 4;
    const int K = g.K, nt = K / BK;
    unsigned voffA[2], voffB[2];
#pragma unroll
    for (int i = 0; i < 2; ++i) { int R, C; stage_rc(tid * 16 + i * 8192, R, C); const int Rb = Epi::PERM ? ((R & ~31) + perm32(R & 31)) : R;
        voffA[i] = (unsigned)(R * K + C) * 2u; voffB[i] = (unsigned)(Rb * K + C) * 2u; }
    const size_t kstep = (size_t)(BK * 2);
    const size_t hstep = (size_t)HALF * K * 2;
    const size_t tstep = 2 * hstep;
    const unsigned ldsw = (unsigned)wid * 1024u;
    const int aoff = lds_byte(wr * 64 + fr, fq * 8), boff = lds_byte(wc * 32 + fr, fq * 8);
#define PG8_SA(b, h) (((b) * 2 + (h)) * HTB)
#define PG8_SB(b, h) ((4 + (b) * 2 + (h)) * HTB)
#define PG8_STAGE(bufoff, gbase, voff) do { _Pragma("unroll") for (int _i = 0; _i < 2; ++_i) \
        __builtin_amdgcn_global_load_lds((const unsigned*)((const char*)(gbase) + (voff)[_i]), (PG8_LAS unsigned*)(lds + (bufoff) + ldsw + _i * 8192), 16, 0, 0); } while (0)
#define PG8_LDA(dst, b, h) do { _Pragma("unroll") for (int m = 0; m < 4; ++m) _Pragma("unroll") for (int k = 0; k < 2; ++k) dst[m][k] = *(const PG8_LAS bf16x8*)(lds + PG8_SA(b, h) + aoff + m * 2048 + k * 1024); } while (0)
#define PG8_LDB(dst, b, h) do { _Pragma("unroll") for (int n = 0; n < 2; ++n) _Pragma("unroll") for (int k = 0; k < 2; ++k) dst[n][k] = *(const PG8_LAS bf16x8*)(lds + PG8_SB(b, h) + boff + n * 2048 + k * 1024); } while (0)
#define PG8_MMA(ai, bj, At, Bt) do { __builtin_amdgcn_s_setprio(1); _Pragma("unroll") for (int m = 0; m < 4; ++m) _Pragma("unroll") for (int n = 0; n < 2; ++n) _Pragma("unroll") for (int k = 0; k < 2; ++k) \
        acc[ai][bj][m][n] = __builtin_amdgcn_mfma_f32_16x16x32_bf16(Bt[n][k], At[m][k], acc[ai][bj][m][n], 0, 0, 0); __builtin_amdgcn_s_setprio(0); } while (0)
#define PG8_WAIT_V(n) asm volatile("s_waitcnt vmcnt(" #n ")" ::: "memory")
#define PG8_WAIT_L(n) asm volatile("s_waitcnt lgkmcnt(" #n ")" ::: "memory")
#define PG8_BAR __builtin_amdgcn_s_barrier()
#define PG8_SCHED __builtin_amdgcn_sched_barrier(0)
    Unit cur, nxt; int ui = 0;
    if (!S.next(0, cur)) return;
    f32x4 acc[2][2][4][2];
#pragma unroll
    for (int a = 0; a < 2; ++a)
#pragma unroll
        for (int b = 0; b < 2; ++b)
#pragma unroll
            for (int m = 0; m < 4; ++m)
#pragma unroll
                for (int n = 0; n < 2; ++n) acc[a][b][m][n] = (f32x4){0.f, 0.f, 0.f, 0.f};
    bf16x8 At[4][2], B0[2][2], B1[2][2];
    const char* cA = (const char*)g.A + (size_t)cur.pm * tstep; const char* cB = (const char*)g.Bt + (size_t)cur.pn * tstep;
    S.a_ready(cur);
    if constexpr (SP2) {
        PG8_STAGE(PG8_SB(0, 0), cB, voffB); PG8_STAGE(PG8_SB(0, 1), cB + hstep, voffB); PG8_STAGE(PG8_SA(0, 0), cA, voffA); PG8_STAGE(PG8_SA(0, 1), cA + hstep, voffA);
        if (wr == 1) PG8_BAR;
        PG8_WAIT_V(2); PG8_BAR;
        PG8_STAGE(PG8_SB(1, 0), cB + kstep, voffB); PG8_STAGE(PG8_SA(1, 0), cA + kstep, voffA); PG8_STAGE(PG8_SB(1, 1), cB + hstep + kstep, voffB);
        PG8_WAIT_V(6); PG8_BAR;
    } else {
        PG8_STAGE(PG8_SB(0, 0), cB, voffB); PG8_STAGE(PG8_SA(0, 0), cA, voffA); PG8_STAGE(PG8_SB(0, 1), cB + hstep, voffB); PG8_STAGE(PG8_SA(0, 1), cA + hstep, voffA);
        if (wr == 1) PG8_BAR;
        PG8_WAIT_V(4); PG8_BAR;
        PG8_STAGE(PG8_SB(1, 0), cB + kstep, voffB); PG8_STAGE(PG8_SA(1, 0), cA + kstep, voffA); PG8_STAGE(PG8_SB(1, 1), cB + hstep + kstep, voffB);
        PG8_WAIT_V(6); PG8_BAR;
    }
    for (;;) {
        const bool has_next = S.next(ui + 1, nxt);
        const char* nA = has_next ? (const char*)g.A + (size_t)nxt.pm * tstep : cA; const char* nB = has_next ? (const char*)g.Bt + (size_t)nxt.pn * tstep : cB;
        for (int t = 0; t < nt; t += 2) {
            const bool last = (t == nt - 2);
            const char* a1 = cA + (size_t)(t + 1) * kstep;
            const char* a2 = last ? nA : cA + (size_t)(t + 2) * kstep; const char* b2 = last ? nB : cB + (size_t)(t + 2) * kstep;
            const char* a3 = a2 + kstep; const char* b3 = b2 + kstep;
            if (last && has_next) S.a_ready(nxt);
            if constexpr (SP2) {
            PG8_LDB(B0, 0, 0); PG8_LDB(B1, 0, 1); PG8_SCHED; PG8_LDA(At, 0, 0); PG8_STAGE(PG8_SA(1, 1), a1 + hstep, voffA);
            PG8_WAIT_V(8); PG8_WAIT_L(0); PG8_BAR; PG8_MMA(0, 0, At, B0); PG8_MMA(0, 1, At, B1); PG8_BAR; PG8_SCHED;
            PG8_LDA(At, 0, 1); PG8_STAGE(PG8_SB(0, 0), b2, voffB); PG8_STAGE(PG8_SB(0, 1), b2 + hstep, voffB); PG8_STAGE(PG8_SA(0, 0), a2, voffA);
            PG8_WAIT_V(8); PG8_WAIT_L(0); PG8_BAR; PG8_MMA(1, 0, At, B0); PG8_MMA(1, 1, At, B1); PG8_BAR; PG8_SCHED;
            PG8_LDB(B0, 1, 0); PG8_LDB(B1, 1, 1); PG8_SCHED; PG8_LDA(At, 1, 0); PG8_STAGE(PG8_SA(0, 1), a2 + hstep, voffA);
            PG8_WAIT_V(8); PG8_WAIT_L(0); PG8_BAR; PG8_MMA(0, 0, At, B0); PG8_MMA(0, 1, At, B1); PG8_BAR; PG8_SCHED;
            PG8_LDA(At, 1, 1); PG8_STAGE(PG8_SB(1, 0), b3, voffB); PG8_STAGE(PG8_SB(1, 1), b3 + hstep, voffB); PG8_STAGE(PG8_SA(1, 0), a3, voffA);
            PG8_WAIT_V(8); PG8_WAIT_L(0); PG8_BAR; PG8_MMA(1, 0, At, B0); PG8_MMA(1, 1, At, B1); PG8_BAR; PG8_SCHED;
            } else {
            PG8_LDB(B0, 0, 0); PG8_SCHED; PG8_LDA(At, 0, 0); PG8_STAGE(PG8_SA(1, 1), a1 + hstep, voffA);
            PG8_WAIT_L(8); PG8_BAR; PG8_WAIT_L(0); PG8_MMA(0, 0, At, B0); PG8_BAR; PG8_SCHED;
            PG8_LDB(B1, 0, 1); PG8_STAGE(PG8_SB(0, 0), b2, voffB);
            PG8_BAR; PG8_WAIT_L(0); PG8_MMA(0, 1, At, B1); PG8_BAR;
            PG8_LDA(At, 0, 1); PG8_STAGE(PG8_SA(0, 0), a2, voffA);
            PG8_BAR; PG8_WAIT_L(0); PG8_MMA(1, 0, At, B0); PG8_BAR; PG8_SCHED;
            PG8_STAGE(PG8_SB(0, 1), b2 + hstep, voffB);
            PG8_WAIT_V(6); PG8_BAR; PG8_MMA(1, 1, At, B1); PG8_BAR;
            PG8_LDB(B0, 1, 0); PG8_SCHED; PG8_LDA(At, 1, 0); PG8_STAGE(PG8_SA(0, 1), a2 + hstep, voffA);
            PG8_WAIT_L(8); PG8_BAR; PG8_WAIT_L(0); PG8_MMA(0, 0, At, B0); PG8_BAR; PG8_SCHED;
            PG8_LDB(B1, 1, 1); PG8_STAGE(PG8_SB(1, 0), b3, voffB);
            PG8_BAR; PG8_WAIT_L(0); PG8_MMA(0, 1, At, B1); PG8_BAR;
            PG8_LDA(At, 1, 1); PG8_STAGE(PG8_SA(1, 0), a3, voffA);
            PG8_BAR; PG8_WAIT_L(0); PG8_MMA(1, 0, At, B0); PG8_BAR; PG8_SCHED;
            PG8_STAGE(PG8_SB(1, 1), b3 + hstep, voffB);
            PG8_WAIT_V(6); PG8_BAR; PG8_MMA(1, 1, At, B1); PG8_BAR;
            }
        }
        if constexpr (ALIGN_EPI) { if (wr == 0) PG8_BAR; }
        if constexpr (!Epi::AFTER_DRAIN) { E(acc, cur, wr, wc, fr, fq); S.done(cur); }
        if (!has_next) break;
#pragma unroll
        for (int a = 0; a < 2; ++a)
#pragma unroll
            for (int b = 0; b < 2; ++b)
#pragma unroll
                for (int m = 0; m < 4; ++m)
#pragma unroll
                    for (int n = 0; n < 2; ++n) acc[a][b][m][n] = (f32x4){0.f, 0.f, 0.f, 0.f};
        cur = nxt; cA = nA; cB = nB; ++ui;
        if constexpr (ALIGN_EPI) { if (wr == 1) PG8_BAR; }
    }
    PG8_WAIT_V(0);
    if constexpr (!ALIGN_EPI) { if (wr == 0) PG8_BAR; }
    PG8_BAR;
    if constexpr (Epi::AFTER_DRAIN) { E.fused(acc, cur, wr, wc, fr, fq, lds, wid, lane); S.done(cur); }
#undef PG8_SA
#undef PG8_SB
#undef PG8_STAGE
#undef PG8_LDA
#undef PG8_LDB
#undef PG8_MMA
#undef PG8_WAIT_V
#undef PG8_WAIT_L
#undef PG8_BAR
#undef PG8_SCHED
}
}

constexpr int BATCH = 2, SEQ = 8192, D = 1024, M = BATCH * SEQ, DFF = 2816, DZ = 2048, DPOOL = 512, DATT = 512, NH = 8, HD = 64, NMOD = 9;
constexpr float EPS = 1e-6f, LOG2E = 1.4426950408889634f, QSCALE = 0.125f * LOG2E;
constexpr int NWAVES = 8, NTHREADS = NWAVES * 64;
#define LAS __attribute__((address_space(3)))
typedef unsigned short bf16;
typedef short bf16x8 __attribute__((ext_vector_type(8)));
typedef short s16x4 __attribute__((ext_vector_type(4)));
typedef float f32x4 __attribute__((ext_vector_type(4)));
typedef float f32x16 __attribute__((ext_vector_type(16)));
typedef unsigned u32x4 __attribute__((ext_vector_type(4)));
typedef unsigned u32x2 __attribute__((ext_vector_type(2)));
typedef float f32x2_t __attribute__((ext_vector_type(2))); typedef __bf16 bf16x2_t __attribute__((ext_vector_type(2)));
__device__ __forceinline__ unsigned cvtpk(float lo, float hi) { f32x2_t v = {lo, hi}; bf16x2_t b = __builtin_convertvector(v, bf16x2_t); return __builtin_bit_cast(unsigned, b); }
__device__ __forceinline__ float bf_lo(unsigned w) { return __builtin_bit_cast(float, w << 16); }
__device__ __forceinline__ float bf_hi(unsigned w) { return __builtin_bit_cast(float, w & 0xffff0000u); }
__device__ __forceinline__ float wave_sum(float v) {
#pragma unroll
    for (int o = 1; o < 64; o <<= 1) v += __shfl_xor(v, o);
    return v;
}

constexpr size_t MiB = 1u << 20;
constexpr size_t WS_BAR = 512 * 1024, WS_BAR_BYTES = 16384;
constexpr size_t WS_QCTR = WS_BAR + 15360;
constexpr size_t WS_SSQ = 600 * 1024;
constexpr size_t WS_CNT = 860 * 1024;
constexpr size_t WS_BIAS = 900 * 1024;
constexpr size_t WS_MOD = 0;
constexpr size_t WS_W1GU = 1 * MiB, WS_W1D = 12 * MiB, WS_WIN = 18 * MiB, WS_WOUT = 22 * MiB, WS_W2GU = 24 * MiB, WS_W2D = 35 * MiB;
constexpr size_t WS_XN = 48 * MiB;
constexpr size_t WS_HID = 80 * MiB;
constexpr size_t WS_Z = 80 * MiB;
constexpr size_t WS_OBR = 144 * MiB;
constexpr size_t WS_ML = 41 * MiB;
constexpr size_t WS_YC = 192 * MiB;
constexpr size_t WS_HB = 224 * MiB;
constexpr size_t WS_END = 256 * MiB;

__device__ __forceinline__ void ada_phase(const float* c, const float* w_ada, const float* b_ada, float* mod, LAS unsigned char* lds) {
    LAS float* sc = (LAS float*)(lds + 81920);
    LAS float* red = sc + 2048;
    const int tid = threadIdx.x, lane = tid & 63, wave = tid >> 6;
    for (int item = blockIdx.x; item < (NMOD * D) / 64; item += gridDim.x) {
        for (int i = tid; i < 2 * D; i += NTHREADS) { const float v = c[i]; sc[i] = v * __builtin_amdgcn_rcpf(1.0f + __builtin_amdgcn_exp2f(-LOG2E * v)); }
        __syncthreads();
        const int cgp = item >> 2, kq = item & 3, col = cgp * 256 + 4 * lane, k0 = kq * 256 + wave * 32;
        const float* wp = w_ada + (size_t)k0 * (NMOD * D) + col;
        f32x4 wv[32];
#pragma unroll
        for (int k = 0; k < 32; ++k) wv[k] = *(const f32x4*)(wp + (size_t)k * (NMOD * D));
        f32x4 a0 = {0.f, 0.f, 0.f, 0.f}, a1 = {0.f, 0.f, 0.f, 0.f};
#pragma unroll
        for (int k = 0; k < 32; ++k) { a0 += wv[k] * sc[k0 + k]; a1 += wv[k] * sc[D + k0 + k]; }
        *(LAS f32x4*)(red + (wave * 2 + 0) * 256 + 4 * lane) = a0; *(LAS f32x4*)(red + (wave * 2 + 1) * 256 + 4 * lane) = a1;
        __syncthreads();
        { const int b = tid >> 8, cc = tid & 255; float s_ = 0.f;
#pragma unroll
          for (int w = 0; w < 8; ++w) s_ += red[(w * 2 + b) * 256 + cc];
          if (kq == 0) s_ += b_ada[cgp * 256 + cc];
          atomicAdd(mod + b * (NMOD * D) + cgp * 256 + cc, s_); }
        __syncthreads();
    }
}
__device__ __forceinline__ void tr_item(const float* W, int ldw, int k0, int n0, bf16* WT, int Kd, int drow0, LAS float* scr, int lane) {
    const int lr = lane >> 3, lc = 4 * (lane & 7);
    f32x4 v[8];
#pragma unroll
    for (int i = 0; i < 8; ++i) v[i] = *(const f32x4*)(W + (size_t)(k0 + lr + 8 * i) * ldw + n0 + lc);
#pragma unroll
    for (int i = 0; i < 8; ++i) { LAS float* d = scr + (lr + 8 * i) * 33 + lc; d[0] = v[i][0]; d[1] = v[i][1]; d[2] = v[i][2]; d[3] = v[i][3]; }
    asm volatile("s_waitcnt lgkmcnt(0)" ::: "memory");
    const int c = lane & 7;
#pragma unroll
    for (int j = 0; j < 4; ++j) { const int n = (lane >> 3) + 8 * j; const LAS float* s = scr + (8 * c) * 33 + n;
        u32x4 o; o.x = cvtpk(s[0 * 33], s[1 * 33]); o.y = cvtpk(s[2 * 33], s[3 * 33]); o.z = cvtpk(s[4 * 33], s[5 * 33]); o.w = cvtpk(s[6 * 33], s[7 * 33]);
        *(u32x4*)(WT + (size_t)(drow0 + n) * Kd + k0 + 8 * c) = o; }
    asm volatile("s_waitcnt lgkmcnt(0)" ::: "memory");
}
__device__ __forceinline__ void fold_item(const float* w_in, const float* w_pool, const float* pool_scale, bf16* WT, int r, LAS float* scr, int lane) {
    const int g = r >> 7, kb = (r >> 3) & 15, cb = r & 7, k = kb * 64 + lane;
    const float* wp = w_pool + (size_t)g * 128 * 128 + cb * 16;
#pragma unroll
    for (int i = 0; i < 8; ++i) { const int j = (lane >> 2) + 16 * i, c4 = 4 * (lane & 3); *(LAS f32x4*)(scr + j * 16 + c4) = *(const f32x4*)(wp + (size_t)j * 128 + c4); }
    asm volatile("s_waitcnt vmcnt(0) lgkmcnt(0)" ::: "memory");
    f32x4 acc[4];
#pragma unroll
    for (int c = 0; c < 4; ++c) acc[c] = (f32x4){0.f, 0.f, 0.f, 0.f};
    const float* wrow = w_in + (size_t)k * DZ + 128 * g;
#pragma unroll 2
    for (int j = 0; j < 128; j += 4) { const f32x4 av = *(const f32x4*)(wrow + j);
#pragma unroll
        for (int jj = 0; jj < 4; ++jj)
#pragma unroll
            for (int c = 0; c < 4; ++c) acc[c] += av[jj] * *(const LAS f32x4*)(scr + (j + jj) * 16 + 4 * c); }
#pragma unroll
    for (int c = 0; c < 16; ++c) { const int col = 128 * g + 16 * cb + c; const float v = acc[c >> 2][c & 3] * pool_scale[col];
        WT[(size_t)col * D + k] = (bf16)(cvtpk(v, v) & 0xffffu); }
    asm volatile("s_waitcnt lgkmcnt(0)" ::: "memory");
}
struct WPtrs { const float *w1g, *w1u, *w1d, *w_in, *w_pool, *pool_scale, *w_out, *w2g, *w2u, *w2d; bf16 *W1GU, *W1D, *WIN, *WOUT, *W2GU, *W2D; };
constexpr int I_FOLD = 512, I_GU = (D / 64) * (DFF / 32), I_DN = (DFF / 64) * (D / 32), I_IN = (D / 64) * ((DZ - DPOOL) / 32), I_OUT = (D / 64) * (D / 32);
constexpr int NITEMS = I_FOLD + 4 * I_GU + 2 * I_DN + I_IN + I_OUT;
constexpr int N_EARLY = 2 * I_GU + I_DN, N_LATE = NITEMS - N_EARLY;
__device__ __forceinline__ void conv_item(const WPtrs& P, int r, LAS float* scr, int lane) {
    if (r >= NITEMS - I_FOLD) { fold_item(P.w_in, P.w_pool, P.pool_scale, P.WIN, r - (NITEMS - I_FOLD), scr, lane); return; }
    if (r < 4 * I_GU) { const int which = r / I_GU; r -= which * I_GU; const int kb = r / (DFF / 32), nb = r % (DFF / 32), n0 = 32 * nb;
        const float* W = which == 0 ? P.w1g : which == 1 ? P.w1u : which == 2 ? P.w2g : P.w2u; bf16* WT = which < 2 ? P.W1GU : P.W2GU;
        tr_item(W, DFF, 64 * kb, n0, WT, D, 256 * (n0 >> 7) + (n0 & 127) + 128 * (which & 1), scr, lane); return; }
    r -= 4 * I_GU;
    if (r < 2 * I_DN) { const int which = r / I_DN; r -= which * I_DN; const int kb = r / (D / 32), nb = r % (D / 32);
        tr_item(which ? P.w2d : P.w1d, D, 64 * kb, 32 * nb, which ? P.W2D : P.W1D, DFF, 32 * nb, scr, lane); return; }
    r -= 2 * I_DN;
    if (r < I_IN) { const int kb = r / ((DZ - DPOOL) / 32), nb = r % ((DZ - DPOOL) / 32), n0 = DPOOL + 32 * nb;
        tr_item(P.w_in, DZ, 64 * kb, n0, P.WIN, D, n0, scr, lane); return; }
    r -= I_IN; { const int kb = r / (D / 32), nb = r % (D / 32); tr_item(P.w_out, D, 64 * kb, 32 * nb, P.WOUT, D, 32 * nb, scr, lane); }
}
__device__ __forceinline__ int early_item(int a) { return a < 2 * I_GU ? a : 4 * I_GU + (a - 2 * I_GU); }
__device__ __forceinline__ int late_item(int b) { return b < 2 * I_GU ? 2 * I_GU + b : (b < 2 * I_GU + I_DN ? 4 * I_GU + I_DN + (b - 2 * I_GU) : 4 * I_GU + 2 * I_DN + (b - 2 * I_GU - I_DN)); }
__device__ __forceinline__ void weights_early(const WPtrs& P, LAS unsigned char* lds) {
    const int lane = threadIdx.x & 63, wave = __builtin_amdgcn_readfirstlane(threadIdx.x >> 6);
    LAS float* scr = (LAS float*)(lds + wave * 9216);
    const bool bal = (gridDim.x == 256);
    const int nada = (NMOD * D) / 64, isada = (int)blockIdx.x < nada;
    const int w0 = bal ? (isada ? (int)blockIdx.x * NWAVES + wave : 2 * nada * NWAVES + ((int)blockIdx.x - nada) * NWAVES + wave) : (int)blockIdx.x * NWAVES + wave;
    const int wstep = bal ? (isada ? nada * NWAVES : (256 - nada) * NWAVES) : (int)gridDim.x * NWAVES;
    const int wend = bal ? (isada ? 2 * nada * NWAVES : N_EARLY) : N_EARLY;
    for (int a = w0; a < wend; a += wstep) conv_item(P, early_item(a), scr, lane);
}
__device__ __forceinline__ void weights_late(const WPtrs& P, int b0, LAS unsigned char* lds) {
    const int lane = threadIdx.x & 63, wave = __builtin_amdgcn_readfirstlane(threadIdx.x >> 6);
    LAS float* scr = (LAS float*)(lds + wave * 9216);
    if ((int)blockIdx.x < b0) return;
    for (int b = ((int)blockIdx.x - b0) * NWAVES + wave; b < N_LATE; b += ((int)gridDim.x - b0) * NWAVES) conv_item(P, late_item(b), scr, lane);
}

__device__ __forceinline__ void prep_rows_phase(const float* h, const float* g, const float* scale, bf16* XN, float* ssq) {
    const int lane = threadIdx.x & 63, wave = threadIdx.x >> 6, gw = blockIdx.x * NWAVES + wave, NGW = gridDim.x * NWAVES;
    f32x4 gg[4];
#pragma unroll
    for (int j = 0; j < 4; ++j) gg[j] = *(const f32x4*)(g + 4 * (64 * j + lane));
    for (int m0 = gw; m0 < M; m0 += 4 * NGW) {
        f32x4 v[4][4];
#pragma unroll
        for (int k = 0; k < 4; ++k) { const int m = m0 + k * NGW; const f32x4* xr = (const f32x4*)(h + (size_t)(m < M ? m : m0) * D) + lane;
#pragma unroll
            for (int j = 0; j < 4; ++j) v[k][j] = xr[64 * j]; }
#pragma unroll
        for (int k = 0; k < 4; ++k) { const int m = m0 + k * NGW; if (m < M) { const int b = m / SEQ; float s = 0.f;
#pragma unroll
            for (int j = 0; j < 4; ++j) s += (v[k][j].x * v[k][j].x + v[k][j].y * v[k][j].y) + (v[k][j].z * v[k][j].z + v[k][j].w * v[k][j].w);
            s = wave_sum(s); if (lane == 0) ssq[m] = s;
            unsigned long long* o8 = (unsigned long long*)(XN + (size_t)m * D) + lane;
#pragma unroll
            for (int j = 0; j < 4; ++j) { const int c = 4 * (64 * j + lane);
                const f32x4 sc = *(const f32x4*)(scale + b * (NMOD * D) + c);
                const f32x4 n = v[k][j] * gg[j] * (sc + 1.0f);
                o8[64 * j] = (unsigned long long)cvtpk(n.x, n.y) | ((unsigned long long)cvtpk(n.z, n.w) << 32); } } }
    }
}
__device__ __forceinline__ void bias_rows(const bf16* WT, int N, const float* shift, float* bias, int gw, int NGW, int lane) {
    f32x4 s0[4], s1[4];
#pragma unroll
    for (int j = 0; j < 4; ++j) { s0[j] = *(const f32x4*)(shift + 16 * lane + 4 * j); s1[j] = *(const f32x4*)(shift + NMOD * D + 16 * lane + 4 * j); }
    for (int n0 = gw; n0 < N; n0 += 4 * NGW) {
        u32x4 w0[4], w1[4];
#pragma unroll
        for (int j = 0; j < 4; ++j) { const int n = n0 + j * NGW; const int nc = n < N ? n : n0; w0[j] = *(const u32x4*)(WT + (size_t)nc * D + 16 * lane); w1[j] = *(const u32x4*)(WT + (size_t)nc * D + 16 * lane + 8); }
#pragma unroll
        for (int j = 0; j < 4; ++j) { const int n = n0 + j * NGW;
            const float f[16] = {bf_lo(w0[j].x), bf_hi(w0[j].x), bf_lo(w0[j].y), bf_hi(w0[j].y), bf_lo(w0[j].z), bf_hi(w0[j].z), bf_lo(w0[j].w), bf_hi(w0[j].w),
                                 bf_lo(w1[j].x), bf_hi(w1[j].x), bf_lo(w1[j].y), bf_hi(w1[j].y), bf_lo(w1[j].z), bf_hi(w1[j].z), bf_lo(w1[j].w), bf_hi(w1[j].w)};
            float a0 = 0.f, a1 = 0.f;
#pragma unroll
            for (int q = 0; q < 4; ++q)
#pragma unroll
                for (int e = 0; e < 4; ++e) { a0 += f[4 * q + e] * s0[q][e]; a1 += f[4 * q + e] * s1[q][e]; }
            a0 = wave_sum(a0); a1 = wave_sum(a1);
            if (lane == 0 && n < N) { bias[n] = a0; bias[N + n] = a1; } }
    }
}
__device__ __forceinline__ void final_norm_phase(const float* h, const float* g, const float* ssq, float* out) {
    const int lane = threadIdx.x & 63, wave = threadIdx.x >> 6, gw = blockIdx.x * NWAVES + wave, NGW = gridDim.x * NWAVES;
    for (int m = gw; m < M; m += NGW) {
        const f32x4* xr = (const f32x4*)(h + (size_t)m * D) + lane;
        f32x4 v[4];
#pragma unroll
        for (int j = 0; j < 4; ++j) v[j] = xr[64 * j];
        const float rstd = 1.0f / sqrtf(ssq[m] * (1.0f / D) + EPS);
        f32x4* o = (f32x4*)(out + (size_t)m * D) + lane;
#pragma unroll
        for (int j = 0; j < 4; ++j) { const f32x4 gg = *(const f32x4*)(g + 4 * (64 * j + lane)); o[64 * j] = v[j] * rstd * gg; }
    }
}
__device__ __forceinline__ void pool_load(const bf16* Z, int m, int lane, u32x4 (&v)[16]) {
    const int t = m % SEQ, w = 2 << (lane >> 4), cnt = (t + 1 < w) ? t + 1 : w;
#pragma unroll
    for (int s = 0; s < 16; ++s) v[s] = *(const u32x4*)(Z + (size_t)(m - (s < cnt ? s : 0)) * DZ + 8 * lane);
}
__device__ __forceinline__ void pool_finish(bf16* YC, int m, int lane, const u32x4 (&v)[16]) {
    const int t = m % SEQ, w = 2 << (lane >> 4), cnt = (t + 1 < w) ? t + 1 : w;
    float sum[8];
#pragma unroll
    for (int e = 0; e < 8; ++e) sum[e] = 0.f;
#pragma unroll
    for (int s = 0; s < 16; ++s) { const float wt = (s < cnt) ? 1.0f : 0.0f;
        sum[0] += wt * bf_lo(v[s].x); sum[1] += wt * bf_hi(v[s].x); sum[2] += wt * bf_lo(v[s].y); sum[3] += wt * bf_hi(v[s].y);
        sum[4] += wt * bf_lo(v[s].z); sum[5] += wt * bf_hi(v[s].z); sum[6] += wt * bf_lo(v[s].w); sum[7] += wt * bf_hi(v[s].w); }
    const float inv = 1.0f / (float)cnt; u32x4 o;
    o.x = cvtpk(sum[0] * inv - bf_lo(v[0].x), sum[1] * inv - bf_hi(v[0].x)); o.y = cvtpk(sum[2] * inv - bf_lo(v[0].y), sum[3] * inv - bf_hi(v[0].y));
    o.z = cvtpk(sum[4] * inv - bf_lo(v[0].z), sum[5] * inv - bf_hi(v[0].z)); o.w = cvtpk(sum[6] * inv - bf_lo(v[0].w), sum[7] * inv - bf_hi(v[0].w));
    *(u32x4*)(YC + (size_t)m * D + 8 * lane) = o;
}
__device__ __forceinline__ void pool_row(const bf16* Z, bf16* YC, int m, int lane) { u32x4 v[16]; pool_load(Z, m, lane, v); pool_finish(YC, m, lane, v); }
__device__ __forceinline__ void merge_phase(const bf16* Z, const bf16* OBR, const float* ML, bf16* YC) {
    const int lane = threadIdx.x & 63, wave = threadIdx.x >> 6, gw = blockIdx.x * NWAVES + wave, NGW = gridDim.x * NWAVES;
    const int head = lane >> 3;
    for (int m0 = gw; m0 < M; m0 += 2 * NGW) {
        u32x4 pa[16], pb[16]; const bool pv1 = m0 + NGW < M;
        pool_load(Z, m0, lane, pa); if (pv1) pool_load(Z, m0 + NGW, lane, pb);
        f32x2_t ml[2][3]; u32x4 v[2][3];
#pragma unroll
        for (int k = 0; k < 2; ++k) { const int m = m0 + k * NGW; if (m < M) {
#pragma unroll
            for (int r = 0; r < 3; ++r) { ml[k][r] = *(const f32x2_t*)(ML + ((size_t)r * M * NH + (size_t)m * NH + head) * 2); v[k][r] = *(const u32x4*)(OBR + (size_t)r * M * DATT + (size_t)m * DATT + 8 * lane); } } }
        pool_finish(YC, m0, lane, pa); if (pv1) pool_finish(YC, m0 + NGW, lane, pb);
#pragma unroll
        for (int k = 0; k < 2; ++k) { const int m = m0 + k * NGW; if (m < M) {
            const float mx = fmaxf(fmaxf(ml[k][0].x, ml[k][1].x), ml[k][2].x);
            float wr[3], W = 0.f;
#pragma unroll
            for (int r = 0; r < 3; ++r) { wr[r] = ml[k][r].y * __builtin_amdgcn_exp2f(ml[k][r].x - mx); W += wr[r]; }
            const float iw = 1.0f / W; float acc[8];
#pragma unroll
            for (int e = 0; e < 8; ++e) acc[e] = 0.f;
#pragma unroll
            for (int r = 0; r < 3; ++r) { const u32x4 vv = v[k][r]; const float ww = wr[r] * iw;
                acc[0] += ww * bf_lo(vv.x); acc[1] += ww * bf_hi(vv.x); acc[2] += ww * bf_lo(vv.y); acc[3] += ww * bf_hi(vv.y);
                acc[4] += ww * bf_lo(vv.z); acc[5] += ww * bf_hi(vv.z); acc[6] += ww * bf_lo(vv.w); acc[7] += ww * bf_hi(vv.w); }
            u32x4 o; o.x = cvtpk(acc[0], acc[1]); o.y = cvtpk(acc[2], acc[3]); o.z = cvtpk(acc[4], acc[5]); o.w = cvtpk(acc[6], acc[7]);
            *(u32x4*)(YC + (size_t)m * D + DPOOL + 8 * lane) = o; } }
    }
}

__device__ __forceinline__ int crow(int r, int hi) { return (r & 3) + 8 * (r >> 2) + 4 * hi; }
__device__ __forceinline__ void attn_phase(const bf16* Z, bf16* OBR, float* ML, bf16* YC, LAS unsigned char* lds) {
    const int lane = threadIdx.x & 63, wave = __builtin_amdgcn_readfirstlane(threadIdx.x >> 6);
    const int q = lane & 31, hi = lane >> 5;
    LAS unsigned char* KW = lds;
    LAS unsigned char* VW = lds + 49152;
    int koff[4];
#pragma unroll
    for (int d0 = 0; d0 < 4; ++d0) koff[d0] = q * 128 + (((2 * d0 + hi) ^ (q & 7)) << 4);
    const int li = lane & 15, qp = li >> 2, pp = li & 3;
    const int swz = ((qp >> 1) & 1) << 2, chunk_l = 2 * ((lane >> 4) & 1) + (pp >> 1);
    const int ab = (4 * hi + qp) * 128 + 8 * (pp & 1) + chunk_l * 16;
    const int va0 = ab + (swz << 4), va1 = ab + ((4 ^ swz) << 4);
    const int drow = lane >> 3, dslot = lane & 7;
    const int kchunk = dslot ^ (drow & 7), vchunk = dslot ^ (((drow >> 1) & 1) << 2);
    f32x16 dqv;
#pragma unroll
    for (int rr = 0; rr < 16; ++rr) dqv[rr] = (float)(q - crow(rr, hi));
#ifndef ATT_REPS
#define ATT_REPS 1
#endif
    for (int rep_ = 0; rep_ < ATT_REPS; ++rep_)
    for (int item = blockIdx.x; item < 3 * BATCH * NH * 32; item += gridDim.x) {
        const int chunk = item & 31, h = (item >> 5) & 7, b = (item >> 8) & 1, r = item >> 9;
        const int lg = 2 * r, dil = 1 << lg, tpr = 256 >> lg, tau0 = chunk * 8, rho = tau0 >> (8 - lg), it0 = tau0 & (tpr - 1), iw0 = 32 * it0 - 128;
        const size_t rowb = (size_t)b * SEQ;
        __syncthreads();
#pragma unroll
        for (int gi = 0; gi < 6; ++gi) { const int g = wave + 8 * gi;
            if (iw0 + 8 * g >= 0) { const bf16* src = Z + (rowb + rho + (size_t)dil * (iw0 + 8 * g + drow)) * DZ + (DPOOL + DATT) + h * HD;
                __builtin_amdgcn_global_load_lds((const unsigned*)(src + kchunk * 8), (LAS unsigned*)(KW + g * 1024), 16, 0, 0);
                __builtin_amdgcn_global_load_lds((const unsigned*)(src + DATT + vchunk * 8), (LAS unsigned*)(VW + g * 1024), 16, 0, 0); } }
        const int it = it0 + wave, tq = rho + dil * (32 * it + q);
        bf16x8 qf[4];
        { const bf16* zq = Z + (rowb + tq) * DZ + DPOOL + h * HD + hi * 8;
#pragma unroll
          for (int d0 = 0; d0 < 4; ++d0) qf[d0] = *(const bf16x8*)(zq + d0 * 16); }
        const float sl2d = __builtin_amdgcn_exp2f(-(float)(h + 1)) * LOG2E * (float)dil;
        const int nt = (it < 4 ? it : 4) + 1;
        asm volatile("s_waitcnt vmcnt(0)" ::: "memory");
        __syncthreads();
        const float nsl = -sl2d;
        const f32x16 cb = dqv * nsl;
        f32x16 s[5]; float mx = -1e30f;
#pragma unroll
        for (int n = 0; n < 5; ++n) {
            if (n < nt) {
                LAS unsigned char* kb = KW + (wave + 4 - n) * 4096;
                f32x16 acc = cb + nsl * (float)(32 * n);
                if (n == 0) {
#pragma unroll
                    for (int rr = 0; rr < 16; ++rr) acc[rr] += fminf(dqv[rr], 0.f) * 1e30f; }
                if (n == 4) {
#pragma unroll
                    for (int rr = 0; rr < 16; ++rr) acc[rr] += fminf(-dqv[rr], 0.f) * 1e30f; }
#pragma unroll
                for (int d0 = 0; d0 < 4; ++d0) acc = __builtin_amdgcn_mfma_f32_32x32x16_bf16(*(const LAS bf16x8*)(kb + koff[d0]), qf[d0], acc, 0, 0, 0);
#pragma unroll
                for (int rr = 0; rr < 16; rr += 2) mx = fmaxf(fmaxf(mx, acc[rr]), acc[rr + 1]);
                s[n] = acc;
            } else {
#pragma unroll
                for (int rr = 0; rr < 16; ++rr) s[n][rr] = -1e30f;
            }
        }
        mx = fmaxf(mx, __shfl_xor(mx, 32));
        u32x4 pw[5][2];
#pragma unroll
        for (int n = 0; n < 5; ++n) {
            const f32x16 t = s[n] - mx;
#pragma unroll
            for (int rr = 0; rr < 16; ++rr) s[n][rr] = __builtin_amdgcn_exp2f(t[rr]);
            pw[n][0].x = cvtpk(s[n][0], s[n][1]); pw[n][0].y = cvtpk(s[n][2], s[n][3]); pw[n][0].z = cvtpk(s[n][4], s[n][5]); pw[n][0].w = cvtpk(s[n][6], s[n][7]);
            pw[n][1].x = cvtpk(s[n][8], s[n][9]); pw[n][1].y = cvtpk(s[n][10], s[n][11]); pw[n][1].z = cvtpk(s[n][12], s[n][13]); pw[n][1].w = cvtpk(s[n][14], s[n][15]);
        }
        float lsum;
        { const f32x16 ps = ((s[0] + s[1]) + (s[2] + s[3])) + s[4];
          lsum = (((ps[0] + ps[1]) + (ps[2] + ps[3])) + ((ps[4] + ps[5]) + (ps[6] + ps[7]))) + (((ps[8] + ps[9]) + (ps[10] + ps[11])) + ((ps[12] + ps[13]) + (ps[14] + ps[15]))); }
        f32x16 o0, o1;
#pragma unroll
        for (int rr = 0; rr < 16; ++rr) { o0[rr] = 0.f; o1[rr] = 0.f; }
#define VTR(off_) __builtin_bit_cast(s16x4, __builtin_amdgcn_ds_read_tr16_b64_v4i16((LAS s16x4*)(vb + (off_))))
#define MKA(lo_, hi_) (bf16x8){lo_[0], lo_[1], lo_[2], lo_[3], hi_[0], hi_[1], hi_[2], hi_[3]}
#pragma unroll
        for (int n = 0; n < 5; ++n) {
            if (n < nt) {
                LAS unsigned char* vb = VW + (wave + 4 - n) * 4096;
                const bf16x8 p0 = __builtin_bit_cast(bf16x8, pw[n][0]), p1 = __builtin_bit_cast(bf16x8, pw[n][1]);
                const s16x4 l0 = VTR(va0), h0 = VTR(va0 + 8 * 128), l1 = VTR(va0 + 16 * 128), h1 = VTR(va0 + 24 * 128);
                const s16x4 l2 = VTR(va1), h2 = VTR(va1 + 8 * 128), l3 = VTR(va1 + 16 * 128), h3 = VTR(va1 + 24 * 128);
                o0 = __builtin_amdgcn_mfma_f32_32x32x16_bf16(MKA(l0, h0), p0, o0, 0, 0, 0);
                o0 = __builtin_amdgcn_mfma_f32_32x32x16_bf16(MKA(l1, h1), p1, o0, 0, 0, 0);
                o1 = __builtin_amdgcn_mfma_f32_32x32x16_bf16(MKA(l2, h2), p0, o1, 0, 0, 0);
                o1 = __builtin_amdgcn_mfma_f32_32x32x16_bf16(MKA(l3, h3), p1, o1, 0, 0, 0);
            }
        }
#undef VTR
#undef MKA
        const float l_tot = lsum + __shfl_xor(lsum, 32), inv = 1.0f / l_tot;
        bf16* orow = OBR + (size_t)r * M * DATT + (rowb + tq) * DATT + h * HD + 4 * hi;
#pragma unroll
        for (int rg = 0; rg < 4; ++rg) {
            u32x2 w0, w1;
            w0.x = cvtpk(o0[4 * rg] * inv, o0[4 * rg + 1] * inv); w0.y = cvtpk(o0[4 * rg + 2] * inv, o0[4 * rg + 3] * inv);
            w1.x = cvtpk(o1[4 * rg] * inv, o1[4 * rg + 1] * inv); w1.y = cvtpk(o1[4 * rg + 2] * inv, o1[4 * rg + 3] * inv);
            *(u32x2*)(orow + 8 * rg) = w0; *(u32x2*)(orow + 32 + 8 * rg) = w1; }
        if (hi == 0) { f32x2_t ml = {mx, l_tot}; *(f32x2_t*)(ML + (size_t)r * M * NH * 2 + ((rowb + tq) * NH + h) * 2) = ml; }
    }
    __syncthreads();
}

#define XB_TMO      128
#define XB_XCNT(j)  (256  + 64 * (j))
#define XB_XSUB(j)  (1280 + 64 * (j))
#define XB_XGEN(j)  (2304 + 64 * (j))
#define XB_TOP      3328
#define XB_TOPGEN   3392
#define XCD_BAR_WORDS 3456
#define XB_SPIN_CAP (1u << 18)

__device__ __forceinline__ unsigned xb_ld(unsigned* p)              { return __hip_atomic_load(p, __ATOMIC_RELAXED, __HIP_MEMORY_SCOPE_AGENT); }
__device__ __forceinline__ unsigned xb_add(unsigned* p, unsigned v) { return __hip_atomic_fetch_add(p, v, __ATOMIC_RELAXED, __HIP_MEMORY_SCOPE_AGENT); }
__device__ __forceinline__ unsigned xb_xcc_id() { return (unsigned)__builtin_amdgcn_s_getreg((3 << 11) | 20) & 0xFu; }
#define XB_SPIN(cond, bar) do { unsigned _sp = 0; while (cond) { __builtin_amdgcn_s_sleep(1); \
    if ((++_sp & 255u) == 0u) { if (xb_ld(&(bar)[XB_TMO])) break; if (_sp > XB_SPIN_CAP) { atomicAdd(&(bar)[XB_TMO], 1u); break; } } } } while (0)

struct XcdBarrier {
    unsigned* bar; unsigned x;
    volatile LAS unsigned* st;
};

__device__ __forceinline__ XcdBarrier xcd_barrier_post(unsigned* bar, volatile LAS unsigned* st) {
    XcdBarrier b; b.bar = bar; b.x = xb_xcc_id(); b.st = st;
    if (threadIdx.x == 0) (void)xb_add(&bar[XB_XCNT(b.x)], 1u);
    return b;
}
__device__ __forceinline__ void xcd_barrier_complete(unsigned* bar, unsigned x, unsigned& nloc, unsigned& nx) {
    const unsigned G = gridDim.x * gridDim.y * gridDim.z;
    unsigned sum, cnt, mine, sp = 0u;
    for (;;) {
        sum = 0u; cnt = 0u; mine = 0u;
#pragma unroll
        for (unsigned j = 0; j < 16; ++j) { const unsigned c = xb_ld(&bar[XB_XCNT(j)]); sum += c; cnt += (c > 0u) ? 1u : 0u; mine = (j == x) ? c : mine; }
        if (sum == G) break;
        __builtin_amdgcn_s_sleep(1);
        if ((++sp & 255u) == 0u) { if (xb_ld(&bar[XB_TMO])) break; if (sp > XB_SPIN_CAP) { atomicAdd(&bar[XB_TMO], 1u); break; } }
    }
    nloc = mine > 0u ? mine : 1u; nx = cnt > 0u ? cnt : 1u;
}

__device__ __forceinline__ void xcd_barrier(const XcdBarrier& b) {
    asm volatile("s_waitcnt vmcnt(0)" ::: "memory");
    __syncthreads();
    if (threadIdx.x == 0) {
        unsigned* bar = b.bar;
        __builtin_amdgcn_s_waitcnt(0);
        unsigned nloc = b.st[0], nx = b.st[1];
        if (nloc == 0u) { xcd_barrier_complete(bar, b.x, nloc, nx); b.st[0] = nloc; b.st[1] = nx; }
        const unsigned old = xb_add(&bar[XB_XSUB(b.x)], 1u);
        const unsigned gen = old / nloc;
        if (old + 1u == (gen + 1u) * nloc) {
            __builtin_amdgcn_fence(__ATOMIC_RELEASE, "agent");
            asm volatile("s_waitcnt vmcnt(0)" ::: "memory");
            const unsigned og = xb_add(&bar[XB_TOP], 1u);
            const unsigned tg = og / nx;
            if (og + 1u == (tg + 1u) * nx) xb_add(&bar[XB_TOPGEN], 1u);
            else XB_SPIN(xb_ld(&bar[XB_TOPGEN]) == tg, bar);
            __builtin_amdgcn_fence(__ATOMIC_ACQUIRE, "agent");
            xb_add(&bar[XB_XGEN(b.x)], 1u);
            asm volatile("s_waitcnt vmcnt(0)" ::: "memory");
        } else {
            XB_SPIN(xb_ld(&bar[XB_XGEN(b.x)]) == gen, bar);
            __builtin_amdgcn_fence(__ATOMIC_ACQUIRE, "agent");
            asm volatile("s_waitcnt vmcnt(0)" ::: "memory");
        }
    }
    __syncthreads();
}

constexpr int LDS_BYTES = 147456;
struct Args { const float* in[18]; float* out; unsigned char* ws; int ph_lo, ph_hi; };
enum { PH_PRO = 0, PH_N1, PH_GU1, PH_DN1, PH_ZIN, PH_ATT, PH_MRG, PH_WOUT, PH_GU2, PH_DN2, PH_COUNT };

__global__ void __launch_bounds__(NTHREADS, 2) fwd_megakernel(Args a) {
    extern __shared__ __attribute__((aligned(16))) unsigned char lds_raw[];
    LAS unsigned char* lds = (LAS unsigned char*)lds_raw;
    cg::grid_group grid = cg::this_grid();
    unsigned char* ws = a.ws;
    const float *x = a.in[0], *c = a.in[1], *w_ada = a.in[2], *b_ada = a.in[3], *g_ffn1 = a.in[4], *g_mix = a.in[8], *g_ffn2 = a.in[13], *g_final = a.in[17];
    float* mod = (float*)(ws + WS_MOD);
    bf16 *W1GU = (bf16*)(ws + WS_W1GU), *W1D = (bf16*)(ws + WS_W1D), *WIN = (bf16*)(ws + WS_WIN), *WOUT = (bf16*)(ws + WS_WOUT), *W2GU = (bf16*)(ws + WS_W2GU), *W2D = (bf16*)(ws + WS_W2D);
    bf16 *XN = (bf16*)(ws + WS_XN), *HID = (bf16*)(ws + WS_HID), *Z = (bf16*)(ws + WS_Z), *OBR = (bf16*)(ws + WS_OBR), *YC = (bf16*)(ws + WS_YC);
    float* ML = (float*)(ws + WS_ML);
    float* SSQ = (float*)(ws + WS_SSQ);
    float *BIAS1 = (float*)(ws + WS_BIAS), *BIASZ = BIAS1 + 2 * 2 * DFF * 2 / 2, *BIAS2 = BIASZ + 2 * DZ;
    bf16* HB = (bf16*)(ws + WS_HB);
    const int G = gridDim.x, bx = blockIdx.x;
    const int lo = a.ph_lo, hi = a.ph_hi;
    volatile LAS unsigned* MISC = (volatile LAS unsigned*)(lds + 131072);
    if (threadIdx.x < 64) MISC[threadIdx.x] = 0u;
    __syncthreads();
    XcdBarrier bar = xcd_barrier_post((unsigned*)(ws + WS_BAR), MISC + 8);
    const WPtrs WP{a.in[5], a.in[6], a.in[7], a.in[9], a.in[10], a.in[11], a.in[12], a.in[14], a.in[15], a.in[16], W1GU, W1D, WIN, WOUT, W2GU, W2D};
    const bool defer_late = (G == 256) && (lo == 0) && (hi == PH_COUNT);
#define IN(k) (lo <= (k) && (k) < hi)
#define GSYNC() do { __syncthreads(); grid.sync(); } while (0)
#define XSYNC() xcd_barrier(bar)
#define SEAM(k) do { if (IN(k) && IN((k) + 1)) XSYNC(); } while (0)
    if (lo > hi) GSYNC();
#ifndef DUP_MASK
#define DUP_MASK 0
#endif
#ifndef EXTRA_SYNCS
#define EXTRA_SYNCS 0
#endif
#define RUNPH(k, BODY) do { if (IN(k)) { BODY; if ((DUP_MASK >> (k)) & 1) { XSYNC(); BODY; } } SEAM(k); } while (0)
#define BODY_PRO { ada_phase(c, w_ada, b_ada, mod, lds); \
        for (int i = bx * NTHREADS + threadIdx.x; i < 3 * M; i += G * NTHREADS) SSQ[M + i] = 0.f; \
        for (int i = bx * NTHREADS + threadIdx.x; i < 64 * 64; i += G * NTHREADS) ((unsigned*)(ws + WS_CNT))[i] = 0u; \
        weights_early(WP, lds); if (!defer_late) weights_late(WP, 0, lds); }
#define BODY_N1 { prep_rows_phase(x, g_ffn1, mod + 1 * D, XN, SSQ); \
        const int gw_ = bx * NWAVES + (threadIdx.x >> 6), NGW_ = G * NWAVES, ln_ = threadIdx.x & 63; \
        bias_rows(W1GU, 2 * DFF, mod + 0 * D, BIAS1, gw_, NGW_, ln_); }
#define BODY_GU(WGU, SSQ_, BIAS_) { pg8::Gemm g{XN, WGU, M, 2 * DFF, D}; pg8::StaticOrder S; S.init(M, 2 * DFF, G, bx); pg8::EpiSwiGLU E{HID, DFF, SSQ_, BIAS_, 2 * DFF, SEQ}; \
        pg8::gemm_phase<pg8::EpiSwiGLU, pg8::StaticOrder, true, true>(lds, g, S, E); }
#define BODY_RES(NEXT_, RESBF_, A_, W_, K_, RES_, MIDX, F_, SSQO_, GN_, SCN_) { pg8::Gemm g{A_, W_, M, D, K_}; pg8::StaticOrder S; S.init(M, D, G, bx); \
        pg8::EpiResid<NEXT_, RESBF_, true> E{RES_, HB, mod + (MIDX) * D, NMOD * D, F_, D, SEQ, SSQO_, XN, GN_, SCN_}; \
        pg8::gemm_phase<pg8::EpiResid<NEXT_, RESBF_, true>, pg8::StaticOrder, true, true>(lds, g, S, E); }
#define BODY_ZIN { pg8::Gemm g{XN, WIN, M, DZ, D}; pg8::StaticOrder S; S.init(M, DZ, G, bx); pg8::EpiZ E{Z, DZ, 2, 4, QSCALE, SSQ + M, BIASZ, DZ, SEQ}; \
        pg8::gemm_phase<pg8::EpiZ, pg8::StaticOrder, true, true>(lds, g, S, E); }
    RUNPH(PH_PRO, BODY_PRO);
    for (int i = 0; i < EXTRA_SYNCS; ++i) XSYNC();
    RUNPH(PH_N1, BODY_N1);
    RUNPH(PH_GU1, { BODY_GU(W1GU, SSQ, BIAS1); if (defer_late) weights_late(WP, 128, lds); });
#if defined(PROBE_DN1)
    if (IN(PH_DN1)) { BODY_RES(true, false, HID, W1D, DFF, x, 2, 0.5f, (float*)(ws + WS_YC), g_mix, mod + 4 * D); XSYNC(); }
#endif
#define BODY_BIASZ { const int gw_ = bx * NWAVES + (threadIdx.x >> 6), NGW_ = G * NWAVES, ln_ = threadIdx.x & 63; bias_rows(WIN, DZ, mod + 3 * D, BIASZ, gw_, NGW_, ln_); }
#define BODY_BIAS2 { const int gw_ = bx * NWAVES + (threadIdx.x >> 6), NGW_ = G * NWAVES, ln_ = threadIdx.x & 63; bias_rows(W2GU, 2 * DFF, mod + 6 * D, BIAS2, gw_, NGW_, ln_); }
    RUNPH(PH_DN1, { BODY_BIASZ; BODY_RES(true, false, HID, W1D, DFF, x, 2, 0.5f, SSQ + M, g_mix, mod + 4 * D); });
    RUNPH(PH_ZIN, BODY_ZIN);
    RUNPH(PH_ATT, { BODY_BIAS2; attn_phase(Z, OBR, ML, YC, lds); });
    RUNPH(PH_MRG, merge_phase(Z, OBR, ML, YC));
    RUNPH(PH_WOUT, BODY_RES(true, true, YC, WOUT, D, HB, 5, 1.0f, SSQ + 2 * M, g_ffn2, mod + 7 * D));
    RUNPH(PH_GU2, BODY_GU(W2GU, SSQ + 2 * M, BIAS2));
#define BODY_DN2 { pg8::Gemm g{HID, W2D, M, D, DFF}; pg8::StaticOrder S; S.init(M, D, G, bx); \
        if (G == 256) { pg8::EpiResidFinal E{HB, a.out, mod + 8 * D, NMOD * D, 0.5f, D, SEQ, SSQ + 3 * M, (unsigned*)(ws + WS_CNT), g_final, 32u}; \
            pg8::gemm_phase<pg8::EpiResidFinal, pg8::StaticOrder, true, true>(lds, g, S, E); } \
        else {     \
            pg8::EpiResid<false, true, false> E{HB, a.out, mod + 8 * D, NMOD * D, 0.5f, D, SEQ, SSQ + 3 * M, XN, g_final, mod}; \
            pg8::gemm_phase<pg8::EpiResid<false, true, false>, pg8::StaticOrder, true, true>(lds, g, S, E); \
            XSYNC(); final_norm_phase(a.out, g_final, SSQ + 3 * M, a.out); } }
    RUNPH(PH_DN2, BODY_DN2);
#undef IN
}

#ifndef MK_COOP
#define MK_COOP 1
#endif
extern "C" void kernel_launch(void* const* d_in, const int* in_sizes, int n_in, void* d_out, int out_size, void* d_ws, size_t ws_size, hipStream_t stream) {
    static int grid = 0;
    if (grid == 0) {
        if (n_in != 18 || in_sizes[0] != M * D || out_size != M * D || ws_size < WS_END) { fprintf(stderr, "kernel_launch: unexpected shapes (n_in %d, in0 %d, out %d, ws %zu)\n", n_in, n_in > 0 ? in_sizes[0] : -1, out_size, ws_size); grid = -1; return; }
        int dev = 0, cus = 0, per_cu = 0;
        if (hipGetDevice(&dev) != hipSuccess || hipDeviceGetAttribute(&cus, hipDeviceAttributeMultiprocessorCount, dev) != hipSuccess) { grid = -1; return; }
        if (hipFuncSetAttribute((const void*)fwd_megakernel, hipFuncAttributeMaxDynamicSharedMemorySize, LDS_BYTES) != hipSuccess) { fprintf(stderr, "kernel_launch: hipFuncSetAttribute failed\n"); grid = -1; return; }
        if (hipOccupancyMaxActiveBlocksPerMultiprocessor(&per_cu, (const void*)fwd_megakernel, NTHREADS, LDS_BYTES) != hipSuccess || per_cu < 1) { fprintf(stderr, "kernel_launch: occupancy query says %d\n", per_cu); per_cu = 1; }
        (void)hipGetLastError();
        grid = cus * 1;
        if (grid > cus * per_cu) grid = cus * per_cu;
    }
    if (grid < 0) return;
    if (hipMemsetAsync((char*)d_ws + WS_MOD, 0, WS_BAR + WS_BAR_BYTES - WS_MOD, stream) != hipSuccess) { fprintf(stderr, "kernel_launch: memset failed\n"); return; }
    Args a{};
    for (int i = 0; i < 18; ++i) a.in[i] = (const float*)d_in[i];
    a.out = (float*)d_out; a.ws = (unsigned char*)d_ws;
#if MK_COOP
    a.ph_lo = 0; a.ph_hi = PH_COUNT;
    void* args[] = {&a};
    hipError_t e = hipLaunchCooperativeKernel((const void*)fwd_megakernel, dim3(grid), dim3(NTHREADS), args, LDS_BYTES, stream);
    if (e != hipSuccess) fprintf(stderr, "cooperative launch failed: %s (grid %d)\n", hipGetErrorString(e), grid);
#else
    for (int ph = 0; ph < PH_COUNT; ++ph) { a.ph_lo = ph; a.ph_hi = ph + 1; hipLaunchKernelGGL(fwd_megakernel, dim3(grid), dim3(NTHREADS), LDS_BYTES, stream, a); }
#endif
}
```

```cpp
#include <hip/hip_runtime.h>
#include <hip/hip_cooperative_groups.h>
#include <cstdio>
#include <cstdint>
namespace cg = cooperative_groups;
namespace pg8 {
#define PG8_LAS __attribute__((address_space(3)))
typedef unsigned short bf16_t;
typedef short bf16x8 __attribute__((ext_vector_type(8)));
typedef float f32x4 __attribute__((ext_vector_type(4)));
typedef unsigned u32x4 __attribute__((ext_vector_type(4)));
constexpr int BM = 256, BK = 64, HALF = 128, HTB = HALF * BK * 2  , STAGE_BYTES = 8 * HTB, NXCD = 8, WGM = 4;

__host__ __device__ __forceinline__ int lds_byte(int r, int c) { const int st = (r >> 4) * 2 + (c >> 5), rr = r & 15, cc = c & 31, ob = rr * 64 + cc * 2; return st * 1024 + (ob ^ (((ob >> 9) & 1) << 5)); }
__host__ __device__ __forceinline__ void stage_rc(int b, int& R, int& C) { const int st = b / 1024, sb = b % 1024, swz = sb ^ (((sb >> 9) & 1) << 5); R = (st >> 1) * 16 + swz / 64; C = (st & 1) * 32 + (swz % 64) / 2; }
__host__ __device__ __forceinline__ int perm32(int rho) { const int n = rho >> 4, i = rho & 15; return 8 * (i >> 2) + 4 * n + (i & 3); }

struct Unit { int pm, pn; };
struct Gemm { const bf16_t* A; const bf16_t* Bt; int M, N, K; };

struct StaticOrder {
    int nM, nN, nwg, G, c;
    __host__ __device__ void init(int M, int N, int G_, int c_) { nM = M / BM; nN = N / BM; nwg = nM * nN; G = G_; c = c_; }
    __host__ __device__ bool next(int i, Unit& u) const {
        const long L = (long)i * G + c; if (L >= nwg) return false;
        int wgid = (int)L; { const int q = nwg / NXCD, r = nwg % NXCD, xcd = wgid % NXCD, off = wgid / NXCD; wgid = (xcd < r ? xcd * (q + 1) : r * (q + 1) + (xcd - r) * q) + off; }
        const int nig = WGM * nN, gid = wgid / nig, fm = gid * WGM, gsz = (nM - fm) < WGM ? (nM - fm) : WGM;
        u.pm = fm + ((wgid % nig) % gsz); u.pn = (wgid % nig) / gsz; return true;
    }
    __device__ __forceinline__ void a_ready(const Unit&) const {}
    __device__ __forceinline__ void done(const Unit&) const {}
};


__device__ __forceinline__ unsigned cvt_pk_bf16(float lo, float hi) { unsigned r; asm volatile("v_cvt_pk_bf16_f32 %0, %1, %2" : "=v"(r) : "v"(lo), "v"(hi)); return r; }
typedef float f32x2v __attribute__((ext_vector_type(2)));
__device__ __forceinline__ f32x2v swiglu2(f32x2v g, f32x2v u) { const f32x2v t = g * (-1.4426950408889634f); f32x2v e; e.x = __builtin_amdgcn_exp2f(t.x); e.y = __builtin_amdgcn_exp2f(t.y);
    const f32x2v d = e + 1.0f; f32x2v r; r.x = __builtin_amdgcn_rcpf(d.x); r.y = __builtin_amdgcn_rcpf(d.y); return (g * u) * r; }
__device__ __forceinline__ float silu_f(float g) { return g * __builtin_amdgcn_rcpf(1.0f + __builtin_amdgcn_exp2f(-1.4426950408889634f * g)); }

__device__ __forceinline__ float rstd_of(const float* ssq, int row) { return __builtin_amdgcn_rsqf(ssq[row] * (1.0f / 1024.0f) + 1e-6f); }
struct EpiSwiGLU {
    static constexpr bool PERM = true, AFTER_DRAIN = false;
    bf16_t* O; int ldc; const float* ssq; const float* bias; int bias_bstride; int rows_per_batch;
    __device__ __forceinline__ void operator()(const f32x4 (&acc)[2][2][4][2], const Unit& u, int wr, int wc, int fr, int fq) const {
        const int row0 = u.pm * BM + wr * 64 + fr, col0 = u.pn * HALF + wc * 32 + 8 * fq;
        const float* bp = bias + (size_t)((u.pm * BM) / rows_per_batch) * bias_bstride + u.pn * BM + wc * 32 + 8 * fq;
        const f32x4 bg0 = *(const f32x4*)(bp), bg1 = *(const f32x4*)(bp + 4), bu0 = *(const f32x4*)(bp + HALF), bu1 = *(const f32x4*)(bp + HALF + 4);
        float rsv[2][4];
#pragma unroll
        for (int ai = 0; ai < 2; ++ai)
#pragma unroll
            for (int m = 0; m < 4; ++m) rsv[ai][m] = rstd_of(ssq, row0 + ai * HALF + m * 16);
#pragma unroll
        for (int ai = 0; ai < 2; ++ai)
#pragma unroll
            for (int m = 0; m < 4; ++m) { const int row = row0 + ai * HALF + m * 16; bf16_t* rowp = O + (size_t)row * ldc + col0; const float rs = rsv[ai][m];
                const f32x4 g0 = acc[ai][0][m][0] * rs + bg0, g1 = acc[ai][0][m][1] * rs + bg1, u0 = acc[ai][1][m][0] * rs + bu0, u1 = acc[ai][1][m][1] * rs + bu1;
                u32x4 w;
                { const f32x2v a = swiglu2((f32x2v){g0[0], g0[1]}, (f32x2v){u0[0], u0[1]}), b = swiglu2((f32x2v){g0[2], g0[3]}, (f32x2v){u0[2], u0[3]});
                  const f32x2v c = swiglu2((f32x2v){g1[0], g1[1]}, (f32x2v){u1[0], u1[1]}), d = swiglu2((f32x2v){g1[2], g1[3]}, (f32x2v){u1[2], u1[3]});
                  w.x = cvt_pk_bf16(a.x, a.y); w.y = cvt_pk_bf16(b.x, b.y); w.z = cvt_pk_bf16(c.x, c.y); w.w = cvt_pk_bf16(d.x, d.y); }
                *(u32x4*)rowp = w; }
    }
};
struct EpiZ {
    static constexpr bool PERM = true, AFTER_DRAIN = false;
    bf16_t* O; int ldc; int sc_lo, sc_hi; float scale; const float* ssq; const float* bias; int bias_bstride; int rows_per_batch;
    __device__ __forceinline__ void operator()(const f32x4 (&acc)[2][2][4][2], const Unit& u, int wr, int wc, int fr, int fq) const {
        const int row0 = u.pm * BM + wr * 64 + fr, col0 = u.pn * BM + wc * 32 + 8 * fq;
        const float sc = (u.pn >= sc_lo && u.pn < sc_hi) ? scale : 1.0f;
        const float* bp = bias + (size_t)((u.pm * BM) / rows_per_batch) * bias_bstride + col0;
        f32x4 bv[2][2];
#pragma unroll
        for (int bj = 0; bj < 2; ++bj) { bv[bj][0] = *(const f32x4*)(bp + bj * HALF) * sc; bv[bj][1] = *(const f32x4*)(bp + bj * HALF + 4) * sc; }
        float rsv[2][4];
#pragma unroll
        for (int ai = 0; ai < 2; ++ai)
#pragma unroll
            for (int m = 0; m < 4; ++m) rsv[ai][m] = rstd_of(ssq, row0 + ai * HALF + m * 16) * sc;
#pragma unroll
        for (int ai = 0; ai < 2; ++ai)
#pragma unroll
            for (int m = 0; m < 4; ++m) { const int row = row0 + ai * HALF + m * 16; bf16_t* rowp = O + (size_t)row * ldc + col0; const float rs = rsv[ai][m];
#pragma unroll
                for (int bj = 0; bj < 2; ++bj) { const f32x4 v0 = acc[ai][bj][m][0] * rs + bv[bj][0], v1 = acc[ai][bj][m][1] * rs + bv[bj][1];
                    u32x4 w; w.x = cvt_pk_bf16(v0[0], v0[1]); w.y = cvt_pk_bf16(v0[2], v0[3]); w.z = cvt_pk_bf16(v1[0], v1[1]); w.w = cvt_pk_bf16(v1[2], v1[3]);
                    *(u32x4*)(rowp + bj * HALF) = w; } }
    }
};
template <bool BF> __device__ __forceinline__ void load_res8(const void* p, size_t off, f32x4& a, f32x4& b) {
    if (BF) { const u32x4 w = *(const u32x4*)((const bf16_t*)p + off);
        a = (f32x4){__builtin_bit_cast(float, w.x << 16), __builtin_bit_cast(float, w.x & 0xffff0000u), __builtin_bit_cast(float, w.y << 16), __builtin_bit_cast(float, w.y & 0xffff0000u)};
        b = (f32x4){__builtin_bit_cast(float, w.z << 16), __builtin_bit_cast(float, w.z & 0xffff0000u), __builtin_bit_cast(float, w.w << 16), __builtin_bit_cast(float, w.w & 0xffff0000u)}; }
    else { a = *(const f32x4*)((const float*)p + off); b = *(const f32x4*)((const float*)p + off + 4); }
}
struct EpiResidFinal {
    static constexpr bool PERM = true, AFTER_DRAIN = false;
    const bf16_t* res; float* out; const float* coef; int mod_bstride; float f; int ldc; int rows_per_batch; float* ssq; unsigned* cnt; const float* g; unsigned want;
    __device__ __forceinline__ void operator()(const f32x4 (&acc)[2][2][4][2], const Unit& u, int wr, int wc, int fr, int fq) const {
        const int row0 = u.pm * BM + wr * 64 + fr, col0 = u.pn * BM + wc * 32 + 8 * fq;
        const size_t boff = (size_t)((u.pm * BM) / rows_per_batch) * mod_bstride;
        f32x4 cv[2][2]; float fl = f; asm volatile("" : "+v"(fl));
#pragma unroll
        for (int bj = 0; bj < 2; ++bj)
#pragma unroll
            for (int n = 0; n < 2; ++n) cv[bj][n] = *(const f32x4*)(coef + boff + col0 + bj * HALF + n * 4) * fl;
        f32x4 h[2][4][2][2];
#pragma unroll
        for (int ai = 0; ai < 2; ++ai)
#pragma unroll
            for (int m = 0; m < 4; ++m) { const int row = row0 + ai * HALF + m * 16; const size_t off = (size_t)row * ldc + col0; float ss = 0.f;
#pragma unroll
                for (int bj = 0; bj < 2; ++bj) { f32x4 rr[2]; load_res8<true>(res, off + bj * HALF, rr[0], rr[1]);
#pragma unroll
                    for (int n = 0; n < 2; ++n) { const f32x4 hv = rr[n] + cv[bj][n] * acc[ai][bj][m][n]; h[ai][m][bj][n] = hv;
                        ss += (hv[0] * hv[0] + hv[1] * hv[1]) + (hv[2] * hv[2] + hv[3] * hv[3]); } }
                ss += __shfl_xor(ss, 16); ss += __shfl_xor(ss, 32);
                if (fq == 0) atomicAdd(ssq + row, ss); }
        asm volatile("s_waitcnt vmcnt(0)" ::: "memory");
        unsigned* cw = cnt + 64 * u.pm;
        if ((threadIdx.x & 63) == 0) __hip_atomic_fetch_add(cw, 1u, __ATOMIC_RELAXED, __HIP_MEMORY_SCOPE_AGENT);
        { unsigned sp = 0; while (__hip_atomic_load(cw, __ATOMIC_RELAXED, __HIP_MEMORY_SCOPE_AGENT) < want) { __builtin_amdgcn_s_sleep(2); if (++sp > (1u << 20)) break; } }
        asm volatile("" ::: "memory");
        f32x4 gv[2][2];
#pragma unroll
        for (int bj = 0; bj < 2; ++bj)
#pragma unroll
            for (int n = 0; n < 2; ++n) gv[bj][n] = *(const f32x4*)(g + col0 + bj * HALF + n * 4);
        float rsv[2][4];
#pragma unroll
        for (int ai = 0; ai < 2; ++ai)
#pragma unroll
            for (int m = 0; m < 4; ++m) { const float sq = __hip_atomic_load(ssq + row0 + ai * HALF + m * 16, __ATOMIC_RELAXED, __HIP_MEMORY_SCOPE_AGENT); rsv[ai][m] = __builtin_amdgcn_rsqf(sq * (1.0f / 1024.0f) + 1e-6f); }
#pragma unroll
        for (int ai = 0; ai < 2; ++ai)
#pragma unroll
            for (int m = 0; m < 4; ++m) { const int row = row0 + ai * HALF + m * 16; const size_t off = (size_t)row * ldc + col0;
                const float rs = rsv[ai][m];
#pragma unroll
                for (int bj = 0; bj < 2; ++bj)
#pragma unroll
                    for (int n = 0; n < 2; ++n) *(f32x4*)(out + off + bj * HALF + n * 4) = h[ai][m][bj][n] * rs * gv[bj][n]; }
    }
};
template <bool NEXT, bool RES_BF, bool OUT_BF> struct EpiResid {
    static constexpr bool PERM = true, AFTER_DRAIN = false;
    const void* res; void* out; const float* coef; int mod_bstride; float f; int ldc; int rows_per_batch; float* ssq_out; bf16_t* an; const float* g_next; const float* scale_next;
    __device__ __forceinline__ void operator()(const f32x4 (&acc)[2][2][4][2], const Unit& u, int wr, int wc, int fr, int fq) const {
        const int row0 = u.pm * BM + wr * 64 + fr, col0 = u.pn * BM + wc * 32 + 8 * fq;
        const size_t boff = (size_t)((u.pm * BM) / rows_per_batch) * mod_bstride;
        f32x4 cv[2][2], gm[2][2]; float fl = f; asm volatile("" : "+v"(fl));
#pragma unroll
        for (int bj = 0; bj < 2; ++bj)
#pragma unroll
            for (int n = 0; n < 2; ++n) { cv[bj][n] = *(const f32x4*)(coef + boff + col0 + bj * HALF + n * 4) * fl;
                if (NEXT) gm[bj][n] = *(const f32x4*)(g_next + col0 + bj * HALF + n * 4) * (*(const f32x4*)(scale_next + boff + col0 + bj * HALF + n * 4) + 1.0f); }
        constexpr int MB = RES_BF ? 4 : 2;
#pragma unroll
        for (int ai = 0; ai < 2; ++ai)
#pragma unroll
            for (int mb = 0; mb < 4; mb += MB) {
                u32x4 rb[MB][2]; f32x4 rf[MB][2][2];
#pragma unroll
                for (int mi = 0; mi < MB; ++mi)
#pragma unroll
                    for (int bj = 0; bj < 2; ++bj) { const size_t off = (size_t)(row0 + ai * HALF + (mb + mi) * 16) * ldc + col0 + bj * HALF;
                        if (RES_BF) rb[mi][bj] = *(const u32x4*)((const bf16_t*)res + off);
                        else { rf[mi][bj][0] = *(const f32x4*)((const float*)res + off); rf[mi][bj][1] = *(const f32x4*)((const float*)res + off + 4); } }
#pragma unroll
                for (int mi = 0; mi < MB; ++mi) { const int m = mb + mi; const int row = row0 + ai * HALF + m * 16; const size_t off = (size_t)row * ldc + col0; float ss = 0.f;
#pragma unroll
                    for (int bj = 0; bj < 2; ++bj) { f32x4 h[2];
                        if (RES_BF) { const u32x4 w = rb[mi][bj];
                            h[0] = (f32x4){__builtin_bit_cast(float, w.x << 16), __builtin_bit_cast(float, w.x & 0xffff0000u), __builtin_bit_cast(float, w.y << 16), __builtin_bit_cast(float, w.y & 0xffff0000u)};
                            h[1] = (f32x4){__builtin_bit_cast(float, w.z << 16), __builtin_bit_cast(float, w.z & 0xffff0000u), __builtin_bit_cast(float, w.w << 16), __builtin_bit_cast(float, w.w & 0xffff0000u)}; }
                        else { h[0] = rf[mi][bj][0]; h[1] = rf[mi][bj][1]; }
#pragma unroll
                        for (int n = 0; n < 2; ++n) { h[n] = h[n] + cv[bj][n] * acc[ai][bj][m][n]; ss += (h[n][0] * h[n][0] + h[n][1] * h[n][1]) + (h[n][2] * h[n][2] + h[n][3] * h[n][3]); }
                        if (OUT_BF) { u32x4 w; w.x = cvt_pk_bf16(h[0][0], h[0][1]); w.y = cvt_pk_bf16(h[0][2], h[0][3]); w.z = cvt_pk_bf16(h[1][0], h[1][1]); w.w = cvt_pk_bf16(h[1][2], h[1][3]);
                            *(u32x4*)((bf16_t*)out + off + bj * HALF) = w; }
                        else { *(f32x4*)((float*)out + off + bj * HALF) = h[0]; *(f32x4*)((float*)out + off + bj * HALF + 4) = h[1]; }
                        if (NEXT) { const f32x4 a0 = h[0] * gm[bj][0], a1 = h[1] * gm[bj][1];
                            u32x4 w; w.x = cvt_pk_bf16(a0[0], a0[1]); w.y = cvt_pk_bf16(a0[2], a0[3]); w.z = cvt_pk_bf16(a1[0], a1[1]); w.w = cvt_pk_bf16(a1[2], a1[3]);
                            *(u32x4*)(an + off + bj * HALF) = w; } }
                    ss += __shfl_xor(ss, 16); ss += __shfl_xor(ss, 32);
                    if (fq == 0) atomicAdd(ssq_out + row, ss); }
            }
    }
};

template <class Epi, class Sched, bool ALIGN_EPI = false, bool SP2 = false>
__device__ __forceinline__ void gemm_phase(PG8_LAS unsigned char* lds, const Gemm g, const Sched& S, const Epi& E) {
    const int tid = threadIdx.x, wid = __builtin_amdgcn_readfirstlane(tid >> 6), lane = tid & 63, wr = wid >> 2, wc = wid & 3, fr = lane & 15, fq = lane >> 4;
    const int K = g.K, nt = K / BK;
    unsigned voffA[2], voffB[2];
#pragma unroll
    for (int i = 0; i < 2; ++i) { int R, C; stage_rc(tid * 16 + i * 8192, R, C); const int Rb = Epi::PERM ? ((R & ~31) + perm32(R & 31)) : R;
        voffA[i] = (unsigned)(R * K + C) * 2u; voffB[i] = (unsigned)(Rb * K + C) * 2u; }
    const size_t kstep = (size_t)(BK * 2);
    const size_t hstep = (size_t)HALF * K * 2;
    const size_t tstep = 2 * hstep;
    const unsigned ldsw = (unsigned)wid * 1024u;
    const int aoff = lds_byte(wr * 64 + fr, fq * 8), boff = lds_byte(wc * 32 + fr, fq * 8);
#define PG8_SA(b, h) (((b) * 2 + (h)) * HTB)
#define PG8_SB(b, h) ((4 + (b) * 2 + (h)) * HTB)
#define PG8_STAGE(bufoff, gbase, voff) do { _Pragma("unroll") for (int _i = 0; _i < 2; ++_i) \
        __builtin_amdgcn_global_load_lds((const unsigned*)((const char*)(gbase) + (voff)[_i]), (PG8_LAS unsigned*)(lds + (bufoff) + ldsw + _i * 8192), 16, 0, 0); } while (0)
#define PG8_LDA(dst, b, h) do { _Pragma("unroll") for (int m = 0; m < 4; ++m) _Pragma("unroll") for (int k = 0; k < 2; ++k) dst[m][k] = *(const PG8_LAS bf16x8*)(lds + PG8_SA(b, h) + aoff + m * 2048 + k * 1024); } while (0)
#define PG8_LDB(dst, b, h) do { _Pragma("unroll") for (int n = 0; n < 2; ++n) _Pragma("unroll") for (int k = 0; k < 2; ++k) dst[n][k] = *(const PG8_LAS bf16x8*)(lds + PG8_SB(b, h) + boff + n * 2048 + k * 1024); } while (0)
#define PG8_MMA(ai, bj, At, Bt) do { __builtin_amdgcn_s_setprio(1); _Pragma("unroll") for (int m = 0; m < 4; ++m) _Pragma("unroll") for (int n = 0; n < 2; ++n) _Pragma("unroll") for (int k = 0; k < 2; ++k) \
        acc[ai][bj][m][n] = __builtin_amdgcn_mfma_f32_16x16x32_bf16(Bt[n][k], At[m][k], acc[ai][bj][m][n], 0, 0, 0); __builtin_amdgcn_s_setprio(0); } while (0)
#define PG8_WAIT_V(n) asm volatile("s_waitcnt vmcnt(" #n ")" ::: "memory")
#define PG8_WAIT_L(n) asm volatile("s_waitcnt lgkmcnt(" #n ")" ::: "memory")
#define PG8_BAR __builtin_amdgcn_s_barrier()
#define PG8_SCHED __builtin_amdgcn_sched_barrier(0)
    Unit cur, nxt; int ui = 0;
    if (!S.next(0, cur)) return;
    f32x4 acc[2][2][4][2];
#pragma unroll
    for (int a = 0; a < 2; ++a)
#pragma unroll
        for (int b = 0; b < 2; ++b)
#pragma unroll
            for (int m = 0; m < 4; ++m)
#pragma unroll
                for (int n = 0; n < 2; ++n) acc[a][b][m][n] = (f32x4){0.f, 0.f, 0.f, 0.f};
    bf16x8 At[4][2], B0[2][2], B1[2][2];
    const char* cA = (const char*)g.A + (size_t)cur.pm * tstep; const char* cB = (const char*)g.Bt + (size_t)cur.pn * tstep;
    S.a_ready(cur);
    if constexpr (SP2) {
        PG8_STAGE(PG8_SB(0, 0), cB, voffB); PG8_STAGE(PG8_SB(0, 1), cB + hstep, voffB); PG8_STAGE(PG8_SA(0, 0), cA, voffA); PG8_STAGE(PG8_SA(0, 1), cA + hstep, voffA);
        if (wr == 1) PG8_BAR;
        PG8_WAIT_V(2); PG8_BAR;
        PG8_STAGE(PG8_SB(1, 0), cB + kstep, voffB); PG8_STAGE(PG8_SA(1, 0), cA + kstep, voffA); PG8_STAGE(PG8_SB(1, 1), cB + hstep + kstep, voffB);
        PG8_WAIT_V(6); PG8_BAR;
    } else {
        PG8_STAGE(PG8_SB(0, 0), cB, voffB); PG8_STAGE(PG8_SA(0, 0), cA, voffA); PG8_STAGE(PG8_SB(0, 1), cB + hstep, voffB); PG8_STAGE(PG8_SA(0, 1), cA + hstep, voffA);
        if (wr == 1) PG8_BAR;
        PG8_WAIT_V(4); PG8_BAR;
        PG8_STAGE(PG8_SB(1, 0), cB + kstep, voffB); PG8_STAGE(PG8_SA(1, 0), cA + kstep, voffA); PG8_STAGE(PG8_SB(1, 1), cB + hstep + kstep, voffB);
        PG8_WAIT_V(6); PG8_BAR;
    }
    for (;;) {
        const bool has_next = S.next(ui + 1, nxt);
        const char* nA = has_next ? (const char*)g.A + (size_t)nxt.pm * tstep : cA; const char* nB = has_next ? (const char*)g.Bt + (size_t)nxt.pn * tstep : cB;
        for (int t = 0; t < nt; t += 2) {
            const bool last = (t == nt - 2);
            const char* a1 = cA + (size_t)(t + 1) * kstep;
            const char* a2 = last ? nA : cA + (size_t)(t + 2) * kstep; const char* b2 = last ? nB : cB + (size_t)(t + 2) * kstep;
            const char* a3 = a2 + kstep; const char* b3 = b2 + kstep;
            if (last && has_next) S.a_ready(nxt);
            if constexpr (SP2) {
            PG8_LDB(B0, 0, 0); PG8_LDB(B1, 0, 1); PG8_SCHED; PG8_LDA(At, 0, 0); PG8_STAGE(PG8_SA(1, 1), a1 + hstep, voffA);
            PG8_WAIT_V(8); PG8_WAIT_L(0); PG8_BAR; PG8_MMA(0, 0, At, B0); PG8_MMA(0, 1, At, B1); PG8_BAR; PG8_SCHED;
            PG8_LDA(At, 0, 1); PG8_STAGE(PG8_SB(0, 0), b2, voffB); PG8_STAGE(PG8_SB(0, 1), b2 + hstep, voffB); PG8_STAGE(PG8_SA(0, 0), a2, voffA);
            PG8_WAIT_V(8); PG8_WAIT_L(0); PG8_BAR; PG8_MMA(1, 0, At, B0); PG8_MMA(1, 1, At, B1); PG8_BAR; PG8_SCHED;
            PG8_LDB(B0, 1, 0); PG8_LDB(B1, 1, 1); PG8_SCHED; PG8_LDA(At, 1, 0); PG8_STAGE(PG8_SA(0, 1), a2 + hstep, voffA);
            PG8_WAIT_V(8); PG8_WAIT_L(0); PG8_BAR; PG8_MMA(0, 0, At, B0); PG8_MMA(0, 1, At, B1); PG8_BAR; PG8_SCHED;
            PG8_LDA(At, 1, 1); PG8_STAGE(PG8_SB(1, 0), b3, voffB); PG8_STAGE(PG8_SB(1, 1), b3 + hstep, voffB); PG8_STAGE(PG8_SA(1, 0), a3, voffA);
            PG8_WAIT_V(8); PG8_WAIT_L(0); PG8_BAR; PG8_MMA(1, 0, At, B0); PG8_MMA(1, 1, At, B1); PG8_BAR; PG8_SCHED;
            } else {
            PG8_LDB(B0, 0, 0); PG8_SCHED; PG8_LDA(At, 0, 0); PG8_STAGE(PG8_SA(1, 1), a1 + hstep, voffA);
            PG8_WAIT_L(8); PG8_BAR; PG8_WAIT_L(0); PG8_MMA(0, 0, At, B0); PG8_BAR; PG8_SCHED;
            PG8_LDB(B1, 0, 1); PG8_STAGE(PG8_SB(0, 0), b2, voffB);
            PG8_BAR; PG8_WAIT_L(0); PG8_MMA(0, 1, At, B1); PG8_BAR;
            PG8_LDA(At, 0, 1); PG8_STAGE(PG8_SA(0, 0), a2, voffA);
            PG8_BAR; PG8_WAIT_L(0); PG8_MMA(1, 0, At, B0); PG8_BAR; PG8_SCHED;
            PG8_STAGE(PG8_SB(0, 1), b2 + hstep, voffB);
            PG8_WAIT_V(6); PG8_BAR; PG8_MMA(1, 1, At, B1); PG8_BAR;
            PG8_LDB(B0, 1, 0); PG8_SCHED; PG8_LDA(At, 1, 0); PG8_STAGE(PG8_SA(0, 1), a2 + hstep, voffA);
            PG8_WAIT_L(8); PG8_BAR; PG8_WAIT_L(0); PG8_MMA(0, 0, At, B0); PG8_BAR; PG8_SCHED;
            PG8_LDB(B1, 1, 1); PG8_STAGE(PG8_SB(1, 0), b3, voffB);
            PG8_BAR; PG8_WAIT_L(0); PG8_MMA(0, 1, At, B1); PG8_BAR;
            PG8_LDA(At, 1, 1); PG8_STAGE(PG8_SA(1, 0), a3, voffA);
            PG8_BAR; PG8_WAIT_L(0); PG8_MMA(1, 0, At, B0); PG8_BAR; PG8_SCHED;
            PG8_STAGE(PG8_SB(1, 1), b3 + hstep, voffB);
            PG8_WAIT_V(6); PG8_BAR; PG8_MMA(1, 1, At, B1); PG8_BAR;
            }
        }
        if constexpr (ALIGN_EPI) { if (wr == 0) PG8_BAR; }
        if constexpr (!Epi::AFTER_DRAIN) { E(acc, cur, wr, wc, fr, fq); S.done(cur); }
        if (!has_next) break;
#pragma unroll
        for (int a = 0; a < 2; ++a)
#pragma unroll
            for (int b = 0; b < 2; ++b)
#pragma unroll
                for (int m = 0; m < 4; ++m)
#pragma unroll
                    for (int n = 0; n < 2; ++n) acc[a][b][m][n] = (f32x4){0.f, 0.f, 0.f, 0.f};
        cur = nxt; cA = nA; cB = nB; ++ui;
        if constexpr (ALIGN_EPI) { if (wr == 1) PG8_BAR; }
    }
    PG8_WAIT_V(0);
    if constexpr (!ALIGN_EPI) { if (wr == 0) PG8_BAR; }
    PG8_BAR;
    if constexpr (Epi::AFTER_DRAIN) { E.fused(acc, cur, wr, wc, fr, fq, lds, wid, lane); S.done(cur); }
#undef PG8_SA
#undef PG8_SB
#undef PG8_STAGE
#undef PG8_LDA
#undef PG8_LDB
#undef PG8_MMA
#undef PG8_WAIT_V
#undef PG8_WAIT_L
#undef PG8_BAR
#undef PG8_SCHED
}
}

constexpr int BATCH = 2, SEQ = 8192, D = 1024, M = BATCH * SEQ, DFF = 2816, DZ = 2048, DPOOL = 512, DATT = 512, NH = 8, HD = 64, NMOD = 9;
constexpr float EPS = 1e-6f, LOG2E = 1.4426950408889634f, QSCALE = 0.125f * LOG2E;
constexpr int NWAVES = 8, NTHREADS = NWAVES * 64;
#define LAS __attribute__((address_space(3)))
typedef unsigned short bf16;
typedef short bf16x8 __attribute__((ext_vector_type(8)));
typedef short s16x4 __attribute__((ext_vector_type(4)));
typedef float f32x4 __attribute__((ext_vector_type(4)));
typedef float f32x16 __attribute__((ext_vector_type(16)));
typedef unsigned u32x4 __attribute__((ext_vector_type(4)));
typedef unsigned u32x2 __attribute__((ext_vector_type(2)));
typedef float f32x2_t __attribute__((ext_vector_type(2))); typedef __bf16 bf16x2_t __attribute__((ext_vector_type(2)));
__device__ __forceinline__ unsigned cvtpk(float lo, float hi) { f32x2_t v = {lo, hi}; bf16x2_t b = __builtin_convertvector(v, bf16x2_t); return __builtin_bit_cast(unsigned, b); }
__device__ __forceinline__ float bf_lo(unsigned w) { return __builtin_bit_cast(float, w << 16); }
__device__ __forceinline__ float bf_hi(unsigned w) { return __builtin_bit_cast(float, w & 0xffff0000u); }
__device__ __forceinline__ float wave_sum(float v) {
#pragma unroll
    for (int o = 1; o < 64; o <<= 1) v += __shfl_xor(v, o);
    return v;
}

constexpr size_t MiB = 1u << 20;
constexpr size_t WS_BAR = 512 * 1024, WS_BAR_BYTES = 16384;
constexpr size_t WS_QCTR = WS_BAR + 15360;
constexpr size_t WS_SSQ = 600 * 1024;
constexpr size_t WS_CNT = 860 * 1024;
constexpr size_t WS_BIAS = 900 * 1024;
constexpr size_t WS_MOD = 0;
constexpr size_t WS_W1GU = 1 * MiB, WS_W1D = 12 * MiB, WS_WIN = 18 * MiB, WS_WOUT = 22 * MiB, WS_W2GU = 24 * MiB, WS_W2D = 35 * MiB;
constexpr size_t WS_XN = 48 * MiB;
constexpr size_t WS_HID = 80 * MiB;
constexpr size_t WS_Z = 80 * MiB;
constexpr size_t WS_OBR = 144 * MiB;
constexpr size_t WS_ML = 41 * MiB;
constexpr size_t WS_YC = 192 * MiB;
constexpr size_t WS_HB = 224 * MiB;
constexpr size_t WS_END = 256 * MiB;

__device__ __forceinline__ void ada_phase(const float* c, const float* w_ada, const float* b_ada, float* mod, LAS unsigned char* lds) {
    LAS float* sc = (LAS float*)(lds + 81920);
    LAS float* red = sc + 2048;
    const int tid = threadIdx.x, lane = tid & 63, wave = tid >> 6;
    for (int item = blockIdx.x; item < (NMOD * D) / 64; item += gridDim.x) {
        for (int i = tid; i < 2 * D; i += NTHREADS) { const float v = c[i]; sc[i] = v * __builtin_amdgcn_rcpf(1.0f + __builtin_amdgcn_exp2f(-LOG2E * v)); }
        __syncthreads();
        const int cgp = item >> 2, kq = item & 3, col = cgp * 256 + 4 * lane, k0 = kq * 256 + wave * 32;
        const float* wp = w_ada + (size_t)k0 * (NMOD * D) + col;
        f32x4 wv[32];
#pragma unroll
        for (int k = 0; k < 32; ++k) wv[k] = *(const f32x4*)(wp + (size_t)k * (NMOD * D));
        f32x4 a0 = {0.f, 0.f, 0.f, 0.f}, a1 = {0.f, 0.f, 0.f, 0.f};
#pragma unroll
        for (int k = 0; k < 32; ++k) { a0 += wv[k] * sc[k0 + k]; a1 += wv[k] * sc[D + k0 + k]; }
        *(LAS f32x4*)(red + (wave * 2 + 0) * 256 + 4 * lane) = a0; *(LAS f32x4*)(red + (wave * 2 + 1) * 256 + 4 * lane) = a1;
        __syncthreads();
        { const int b = tid >> 8, cc = tid & 255; float s_ = 0.f;
#pragma unroll
          for (int w = 0; w < 8; ++w) s_ += red[(w * 2 + b) * 256 + cc];
          if (kq == 0) s_ += b_ada[cgp * 256 + cc];
          atomicAdd(mod + b * (NMOD * D) + cgp * 256 + cc, s_); }
        __syncthreads();
    }
}
__device__ __forceinline__ void tr_item(const float* W, int ldw, int k0, int n0, bf16* WT, int Kd, int drow0, LAS float* scr, int lane) {
    const int lr = lane >> 3, lc = 4 * (lane & 7);
    f32x4 v[8];
#pragma unroll
    for (int i = 0; i < 8; ++i) v[i] = *(const f32x4*)(W + (size_t)(k0 + lr + 8 * i) * ldw + n0 + lc);
#pragma unroll
    for (int i = 0; i < 8; ++i) { LAS float* d = scr + (lr + 8 * i) * 33 + lc; d[0] = v[i][0]; d[1] = v[i][1]; d[2] = v[i][2]; d[3] = v[i][3]; }
    asm volatile("s_waitcnt lgkmcnt(0)" ::: "memory");
    const int c = lane & 7;
#pragma unroll
    for (int j = 0; j < 4; ++j) { const int n = (lane >> 3) + 8 * j; const LAS float* s = scr + (8 * c) * 33 + n;
        u32x4 o; o.x = cvtpk(s[0 * 33], s[1 * 33]); o.y = cvtpk(s[2 * 33], s[3 * 33]); o.z = cvtpk(s[4 * 33], s[5 * 33]); o.w = cvtpk(s[6 * 33], s[7 * 33]);
        *(u32x4*)(WT + (size_t)(drow0 + n) * Kd + k0 + 8 * c) = o; }
    asm volatile("s_waitcnt lgkmcnt(0)" ::: "memory");
}
__device__ __forceinline__ void fold_item(const float* w_in, const float* w_pool, const float* pool_scale, bf16* WT, int r, LAS float* scr, int lane) {
    const int g = r >> 7, kb = (r >> 3) & 15, cb = r & 7, k = kb * 64 + lane;
    const float* wp = w_pool + (size_t)g * 128 * 128 + cb * 16;
#pragma unroll
    for (int i = 0; i < 8; ++i) { const int j = (lane >> 2) + 16 * i, c4 = 4 * (lane & 3); *(LAS f32x4*)(scr + j * 16 + c4) = *(const f32x4*)(wp + (size_t)j * 128 + c4); }
    asm volatile("s_waitcnt vmcnt(0) lgkmcnt(0)" ::: "memory");
    f32x4 acc[4];
#pragma unroll
    for (int c = 0; c < 4; ++c) acc[c] = (f32x4){0.f, 0.f, 0.f, 0.f};
    const float* wrow = w_in + (size_t)k * DZ + 128 * g;
#pragma unroll 2
    for (int j = 0; j < 128; j += 4) { const f32x4 av = *(const f32x4*)(wrow + j);
#pragma unroll
        for (int jj = 0; jj < 4; ++jj)
#pragma unroll
            for (int c = 0; c < 4; ++c) acc[c] += av[jj] * *(const LAS f32x4*)(scr + (j + jj) * 16 + 4 * c); }
#pragma unroll
    for (int c = 0; c < 16; ++c) { const int col = 128 * g + 16 * cb + c; const float v = acc[c >> 2][c & 3] * pool_scale[col];
        WT[(size_t)col * D + k] = (bf16)(cvtpk(v, v) & 0xffffu); }
    asm volatile("s_waitcnt lgkmcnt(0)" ::: "memory");
}
struct WPtrs { const float *w1g, *w1u, *w1d, *w_in, *w_pool, *pool_scale, *w_out, *w2g, *w2u, *w2d; bf16 *W1GU, *W1D, *WIN, *WOUT, *W2GU, *W2D; };
constexpr int I_FOLD = 512, I_GU = (D / 64) * (DFF / 32), I_DN = (DFF / 64) * (D / 32), I_IN = (D / 64) * ((DZ - DPOOL) / 32), I_OUT = (D / 64) * (D / 32);
constexpr int NITEMS = I_FOLD + 4 * I_GU + 2 * I_DN + I_IN + I_OUT;
constexpr int N_EARLY = 2 * I_GU + I_DN, N_LATE = NITEMS - N_EARLY;
__device__ __forceinline__ void conv_item(const WPtrs& P, int r, LAS float* scr, int lane) {
    if (r >= NITEMS - I_FOLD) { fold_item(P.w_in, P.w_pool, P.pool_scale, P.WIN, r - (NITEMS - I_FOLD), scr, lane); return; }
    if (r < 4 * I_GU) { const int which = r / I_GU; r -= which * I_GU; const int kb = r / (DFF / 32), nb = r % (DFF / 32), n0 = 32 * nb;
        const float* W = which == 0 ? P.w1g : which == 1 ? P.w1u : which == 2 ? P.w2g : P.w2u; bf16* WT = which < 2 ? P.W1GU : P.W2GU;
        tr_item(W, DFF, 64 * kb, n0, WT, D, 256 * (n0 >> 7) + (n0 & 127) + 128 * (which & 1), scr, lane); return; }
    r -= 4 * I_GU;
    if (r < 2 * I_DN) { const int which = r / I_DN; r -= which * I_DN; const int kb = r / (D / 32), nb = r % (D / 32);
        tr_item(which ? P.w2d : P.w1d, D, 64 * kb, 32 * nb, which ? P.W2D : P.W1D, DFF, 32 * nb, scr, lane); return; }
    r -= 2 * I_DN;
    if (r < I_IN) { const int kb = r / ((DZ - DPOOL) / 32), nb = r % ((DZ - DPOOL) / 32), n0 = DPOOL + 32 * nb;
        tr_item(P.w_in, DZ, 64 * kb, n0, P.WIN, D, n0, scr, lane); return; }
    r -= I_IN; { const int kb = r / (D / 32), nb = r % (D / 32); tr_item(P.w_out, D, 64 * kb, 32 * nb, P.WOUT, D, 32 * nb, scr, lane); }
}
__device__ __forceinline__ int early_item(int a) { return a < 2 * I_GU ? a : 4 * I_GU + (a - 2 * I_GU); }
__device__ __forceinline__ int late_item(int b) { return b < 2 * I_GU ? 2 * I_GU + b : (b < 2 * I_GU + I_DN ? 4 * I_GU + I_DN + (b - 2 * I_GU) : 4 * I_GU + 2 * I_DN + (b - 2 * I_GU - I_DN)); }
__device__ __forceinline__ void weights_early(const WPtrs& P, LAS unsigned char* lds) {
    const int lane = threadIdx.x & 63, wave = __builtin_amdgcn_readfirstlane(threadIdx.x >> 6);
    LAS float* scr = (LAS float*)(lds + wave * 9216);
    const bool bal = (gridDim.x == 256);
    const int nada = (NMOD * D) / 64, isada = (int)blockIdx.x < nada;
    const int w0 = bal ? (isada ? (int)blockIdx.x * NWAVES + wave : 2 * nada * NWAVES + ((int)blockIdx.x - nada) * NWAVES + wave) : (int)blockIdx.x * NWAVES + wave;
    const int wstep = bal ? (isada ? nada * NWAVES : (256 - nada) * NWAVES) : (int)gridDim.x * NWAVES;
    const int wend = bal ? (isada ? 2 * nada * NWAVES : N_EARLY) : N_EARLY;
    for (int a = w0; a < wend; a += wstep) conv_item(P, early_item(a), scr, lane);
}
__device__ __forceinline__ void weights_late(const WPtrs& P, int b0, LAS unsigned char* lds) {
    const int lane = threadIdx.x & 63, wave = __builtin_amdgcn_readfirstlane(threadIdx.x >> 6);
    LAS float* scr = (LAS float*)(lds + wave * 9216);
    if ((int)blockIdx.x < b0) return;
    for (int b = ((int)blockIdx.x - b0) * NWAVES + wave; b < N_LATE; b += ((int)gridDim.x - b0) * NWAVES) conv_item(P, late_item(b), scr, lane);
}

__device__ __forceinline__ void prep_rows_phase(const float* h, const float* g, const float* scale, bf16* XN, float* ssq) {
    const int lane = threadIdx.x & 63, wave = threadIdx.x >> 6, gw = blockIdx.x * NWAVES + wave, NGW = gridDim.x * NWAVES;
    f32x4 gg[4];
#pragma unroll
    for (int j = 0; j < 4; ++j) gg[j] = *(const f32x4*)(g + 4 * (64 * j + lane));
    constexpr int RB = 8;
    for (int m0 = gw; m0 < M; m0 += RB * NGW) {
        f32x4 v[RB][4];
#pragma unroll
        for (int k = 0; k < RB; ++k) { const int m = m0 + k * NGW; const f32x4* xr = (const f32x4*)(h + (size_t)(m < M ? m : m0) * D) + lane;
#pragma unroll
            for (int j = 0; j < 4; ++j) v[k][j] = xr[64 * j]; }
#pragma unroll
        for (int k = 0; k < RB; ++k) { const int m = m0 + k * NGW; if (m < M) { const int b = m / SEQ; float s = 0.f;
#pragma unroll
            for (int j = 0; j < 4; ++j) s += (v[k][j].x * v[k][j].x + v[k][j].y * v[k][j].y) + (v[k][j].z * v[k][j].z + v[k][j].w * v[k][j].w);
            s = wave_sum(s); if (lane == 0) ssq[m] = s;
            unsigned long long* o8 = (unsigned long long*)(XN + (size_t)m * D) + lane;
#pragma unroll
            for (int j = 0; j < 4; ++j) { const int c = 4 * (64 * j + lane);
                const f32x4 sc = *(const f32x4*)(scale + b * (NMOD * D) + c);
                const f32x4 n = v[k][j] * gg[j] * (sc + 1.0f);
                o8[64 * j] = (unsigned long long)cvtpk(n.x, n.y) | ((unsigned long long)cvtpk(n.z, n.w) << 32); } } }
    }
}
__device__ __forceinline__ void bias_rows(const bf16* WT, int N, const float* shift, float* bias, int gw, int NGW, int lane) {
    f32x4 s0[4], s1[4];
#pragma unroll
    for (int j = 0; j < 4; ++j) { s0[j] = *(const f32x4*)(shift + 16 * lane + 4 * j); s1[j] = *(const f32x4*)(shift + NMOD * D + 16 * lane + 4 * j); }
    for (int n0 = gw; n0 < N; n0 += 4 * NGW) {
        u32x4 w0[4], w1[4];
#pragma unroll
        for (int j = 0; j < 4; ++j) { const int n = n0 + j * NGW; const int nc = n < N ? n : n0; w0[j] = *(const u32x4*)(WT + (size_t)nc * D + 16 * lane); w1[j] = *(const u32x4*)(WT + (size_t)nc * D + 16 * lane + 8); }
#pragma unroll
        for (int j = 0; j < 4; ++j) { const int n = n0 + j * NGW;
            const float f[16] = {bf_lo(w0[j].x), bf_hi(w0[j].x), bf_lo(w0[j].y), bf_hi(w0[j].y), bf_lo(w0[j].z), bf_hi(w0[j].z), bf_lo(w0[j].w), bf_hi(w0[j].w),
                                 bf_lo(w1[j].x), bf_hi(w1[j].x), bf_lo(w1[j].y), bf_hi(w1[j].y), bf_lo(w1[j].z), bf_hi(w1[j].z), bf_lo(w1[j].w), bf_hi(w1[j].w)};
            float a0 = 0.f, a1 = 0.f;
#pragma unroll
            for (int q = 0; q < 4; ++q)
#pragma unroll
                for (int e = 0; e < 4; ++e) { a0 += f[4 * q + e] * s0[q][e]; a1 += f[4 * q + e] * s1[q][e]; }
            a0 = wave_sum(a0); a1 = wave_sum(a1);
            if (lane == 0 && n < N) { bias[n] = a0; bias[N + n] = a1; } }
    }
}
__device__ __forceinline__ void final_norm_phase(const float* h, const float* g, const float* ssq, float* out) {
    const int lane = threadIdx.x & 63, wave = threadIdx.x >> 6, gw = blockIdx.x * NWAVES + wave, NGW = gridDim.x * NWAVES;
    for (int m = gw; m < M; m += NGW) {
        const f32x4* xr = (const f32x4*)(h + (size_t)m * D) + lane;
        f32x4 v[4];
#pragma unroll
        for (int j = 0; j < 4; ++j) v[j] = xr[64 * j];
        const float rstd = 1.0f / sqrtf(ssq[m] * (1.0f / D) + EPS);
        f32x4* o = (f32x4*)(out + (size_t)m * D) + lane;
#pragma unroll
        for (int j = 0; j < 4; ++j) { const f32x4 gg = *(const f32x4*)(g + 4 * (64 * j + lane)); o[64 * j] = v[j] * rstd * gg; }
    }
}
__device__ __forceinline__ void pool_load(const bf16* Z, int m, int lane, u32x4 (&v)[16]) {
    const int t = m % SEQ, w = 2 << (lane >> 4), cnt = (t + 1 < w) ? t + 1 : w;
#pragma unroll
    for (int s = 0; s < 16; ++s) v[s] = *(const u32x4*)(Z + (size_t)(m - (s < cnt ? s : 0)) * DZ + 8 * lane);
}
__device__ __forceinline__ void pool_finish(bf16* YC, int m, int lane, const u32x4 (&v)[16]) {
    const int t = m % SEQ, w = 2 << (lane >> 4), cnt = (t + 1 < w) ? t + 1 : w;
    float sum[8];
#pragma unroll
    for (int e = 0; e < 8; ++e) sum[e] = 0.f;
#pragma unroll
    for (int s = 0; s < 16; ++s) { const float wt = (s < cnt) ? 1.0f : 0.0f;
        sum[0] += wt * bf_lo(v[s].x); sum[1] += wt * bf_hi(v[s].x); sum[2] += wt * bf_lo(v[s].y); sum[3] += wt * bf_hi(v[s].y);
        sum[4] += wt * bf_lo(v[s].z); sum[5] += wt * bf_hi(v[s].z); sum[6] += wt * bf_lo(v[s].w); sum[7] += wt * bf_hi(v[s].w); }
    const float inv = 1.0f / (float)cnt; u32x4 o;
    o.x = cvtpk(sum[0] * inv - bf_lo(v[0].x), sum[1] * inv - bf_hi(v[0].x)); o.y = cvtpk(sum[2] * inv - bf_lo(v[0].y), sum[3] * inv - bf_hi(v[0].y));
    o.z = cvtpk(sum[4] * inv - bf_lo(v[0].z), sum[5] * inv - bf_hi(v[0].z)); o.w = cvtpk(sum[6] * inv - bf_lo(v[0].w), sum[7] * inv - bf_hi(v[0].w));
    *(u32x4*)(YC + (size_t)m * D + 8 * lane) = o;
}
__device__ __forceinline__ void pool_row(const bf16* Z, bf16* YC, int m, int lane) { u32x4 v[16]; pool_load(Z, m, lane, v); pool_finish(YC, m, lane, v); }
__device__ __forceinline__ void merge_phase(const bf16* Z, const bf16* OBR, const float* ML, bf16* YC) {
    const int lane = threadIdx.x & 63, wave = threadIdx.x >> 6, gw = blockIdx.x * NWAVES + wave, NGW = gridDim.x * NWAVES;
    const int head = lane >> 3;
    const bool contig = (M % (2 * NGW) == 0); const int rpw = M / NGW;
    for (int k_ = 0; ; ++k_) {
        const int m0 = contig ? gw * rpw + 2 * k_ : gw + 2 * k_ * NGW, mstep = contig ? 1 : NGW;
        if (m0 >= M || (contig && 2 * k_ >= rpw)) break;
        u32x4 pa[16], pb[16]; const bool pv1 = m0 + mstep < M;
        pool_load(Z, m0, lane, pa); if (pv1) pool_load(Z, m0 + mstep, lane, pb);
        f32x2_t ml[2][3]; u32x4 v[2][3];
#pragma unroll
        for (int k = 0; k < 2; ++k) { const int m = m0 + k * mstep; if (m < M) {
#pragma unroll
            for (int r = 0; r < 3; ++r) { ml[k][r] = *(const f32x2_t*)(ML + ((size_t)r * M * NH + (size_t)m * NH + head) * 2); v[k][r] = *(const u32x4*)(OBR + (size_t)r * M * DATT + (size_t)m * DATT + 8 * lane); } } }
        pool_finish(YC, m0, lane, pa); if (pv1) pool_finish(YC, m0 + mstep, lane, pb);
#pragma unroll
        for (int k = 0; k < 2; ++k) { const int m = m0 + k * mstep; if (m < M) {
            const float mx = fmaxf(fmaxf(ml[k][0].x, ml[k][1].x), ml[k][2].x);
            float wr[3], W = 0.f;
#pragma unroll
            for (int r = 0; r < 3; ++r) { wr[r] = ml[k][r].y * __builtin_amdgcn_exp2f(ml[k][r].x - mx); W += wr[r]; }
            const float iw = 1.0f / W; float acc[8];
#pragma unroll
            for (int e = 0; e < 8; ++e) acc[e] = 0.f;
#pragma unroll
            for (int r = 0; r < 3; ++r) { const u32x4 vv = v[k][r]; const float ww = wr[r] * iw;
                acc[0] += ww * bf_lo(vv.x); acc[1] += ww * bf_hi(vv.x); acc[2] += ww * bf_lo(vv.y); acc[3] += ww * bf_hi(vv.y);
                acc[4] += ww * bf_lo(vv.z); acc[5] += ww * bf_hi(vv.z); acc[6] += ww * bf_lo(vv.w); acc[7] += ww * bf_hi(vv.w); }
            u32x4 o; o.x = cvtpk(acc[0], acc[1]); o.y = cvtpk(acc[2], acc[3]); o.z = cvtpk(acc[4], acc[5]); o.w = cvtpk(acc[6], acc[7]);
            *(u32x4*)(YC + (size_t)m * D + DPOOL + 8 * lane) = o; } }
    }
}

__device__ __forceinline__ int crow(int r, int hi) { return (r & 3) + 8 * (r >> 2) + 4 * hi; }
__device__ __forceinline__ void attn_phase(const bf16* Z, bf16* OBR, float* ML, bf16* YC, LAS unsigned char* lds) {
    const int lane = threadIdx.x & 63, wave = __builtin_amdgcn_readfirstlane(threadIdx.x >> 6);
    const int q = lane & 31, hi = lane >> 5;
    LAS unsigned char* KW = lds;
    LAS unsigned char* VW = lds + 49152;
    int koff[4];
#pragma unroll
    for (int d0 = 0; d0 < 4; ++d0) koff[d0] = q * 128 + (((2 * d0 + hi) ^ (q & 7)) << 4);
    const int li = lane & 15, qp = li >> 2, pp = li & 3;
    const int swz = ((qp >> 1) & 1) << 2, chunk_l = 2 * ((lane >> 4) & 1) + (pp >> 1);
    const int ab = (4 * hi + qp) * 128 + 8 * (pp & 1) + chunk_l * 16;
    const int va0 = ab + (swz << 4), va1 = ab + ((4 ^ swz) << 4);
    const int drow = lane >> 3, dslot = lane & 7;
    const int kchunk = dslot ^ (drow & 7), vchunk = dslot ^ (((drow >> 1) & 1) << 2);
    f32x16 dqv;
#pragma unroll
    for (int rr = 0; rr < 16; ++rr) dqv[rr] = (float)(q - crow(rr, hi));
    const bool xmap = (gridDim.x == 256);
    for (int i_ = 0; ; ++i_) {
        const int item = xmap ? ((int)(blockIdx.x & 7) * 192 + 32 * i_ + (int)(blockIdx.x >> 3)) : ((int)blockIdx.x + i_ * (int)gridDim.x);
        if (item >= 3 * BATCH * NH * 32 || (xmap && i_ >= 6)) break;
        const int chunk = item & 31, h = (item >> 5) & 7, b = (item >> 8) & 1, r = item >> 9;
        const int lg = 2 * r, dil = 1 << lg, tpr = 256 >> lg, tau0 = chunk * 8, rho = tau0 >> (8 - lg), it0 = tau0 & (tpr - 1), iw0 = 32 * it0 - 128;
        const size_t rowb = (size_t)b * SEQ;
        asm volatile("s_waitcnt lgkmcnt(0)" ::: "memory"); __builtin_amdgcn_s_barrier();
#pragma unroll
        for (int gi = 0; gi < 6; ++gi) { const int g = wave + 8 * gi;
            if (iw0 + 8 * g >= 0) { const bf16* src = Z + (rowb + rho + (size_t)dil * (iw0 + 8 * g + drow)) * DZ + (DPOOL + DATT) + h * HD;
                __builtin_amdgcn_global_load_lds((const unsigned*)(src + kchunk * 8), (LAS unsigned*)(KW + g * 1024), 16, 0, 0);
                __builtin_amdgcn_global_load_lds((const unsigned*)(src + DATT + vchunk * 8), (LAS unsigned*)(VW + g * 1024), 16, 0, 0); } }
        const int it = it0 + wave, tq = rho + dil * (32 * it + q);
        bf16x8 qf[4];
        { const bf16* zq = Z + (rowb + tq) * DZ + DPOOL + h * HD + hi * 8;
#pragma unroll
          for (int d0 = 0; d0 < 4; ++d0) qf[d0] = *(const bf16x8*)(zq + d0 * 16); }
        const float sl2d = __builtin_amdgcn_exp2f(-(float)(h + 1)) * LOG2E * (float)dil;
        const int nt = (it < 4 ? it : 4) + 1;
        asm volatile("s_waitcnt vmcnt(0)" ::: "memory");
        __syncthreads();
        const float nsl = -sl2d;
        const f32x16 cb = dqv * nsl;
        f32x16 s[5]; float mx = -1e30f;
#pragma unroll
        for (int n = 0; n < 5; ++n) {
            if (n < nt) {
                LAS unsigned char* kb = KW + (wave + 4 - n) * 4096;
                f32x16 acc = cb + nsl * (float)(32 * n);
                if (n == 0) {
#pragma unroll
                    for (int rr = 0; rr < 16; ++rr) acc[rr] += fminf(dqv[rr], 0.f) * 1e30f; }
                if (n == 4) {
#pragma unroll
                    for (int rr = 0; rr < 16; ++rr) acc[rr] += fminf(-dqv[rr], 0.f) * 1e30f; }
#pragma unroll
                for (int d0 = 0; d0 < 4; ++d0) acc = __builtin_amdgcn_mfma_f32_32x32x16_bf16(*(const LAS bf16x8*)(kb + koff[d0]), qf[d0], acc, 0, 0, 0);
#pragma unroll
                for (int rr = 0; rr < 16; rr += 2) mx = fmaxf(fmaxf(mx, acc[rr]), acc[rr + 1]);
                s[n] = acc;
            } else {
#pragma unroll
                for (int rr = 0; rr < 16; ++rr) s[n][rr] = -1e30f;
            }
        }
        mx = fmaxf(mx, __shfl_xor(mx, 32));
        u32x4 pw[5][2];
#pragma unroll
        for (int n = 0; n < 5; ++n) {
            const f32x16 t = s[n] - mx;
#pragma unroll
            for (int rr = 0; rr < 16; ++rr) s[n][rr] = __builtin_amdgcn_exp2f(t[rr]);
            pw[n][0].x = cvtpk(s[n][0], s[n][1]); pw[n][0].y = cvtpk(s[n][2], s[n][3]); pw[n][0].z = cvtpk(s[n][4], s[n][5]); pw[n][0].w = cvtpk(s[n][6], s[n][7]);
            pw[n][1].x = cvtpk(s[n][8], s[n][9]); pw[n][1].y = cvtpk(s[n][10], s[n][11]); pw[n][1].z = cvtpk(s[n][12], s[n][13]); pw[n][1].w = cvtpk(s[n][14], s[n][15]);
        }
        float lsum;
        { const f32x16 ps = ((s[0] + s[1]) + (s[2] + s[3])) + s[4];
          lsum = (((ps[0] + ps[1]) + (ps[2] + ps[3])) + ((ps[4] + ps[5]) + (ps[6] + ps[7]))) + (((ps[8] + ps[9]) + (ps[10] + ps[11])) + ((ps[12] + ps[13]) + (ps[14] + ps[15]))); }
        f32x16 o0, o1;
#pragma unroll
        for (int rr = 0; rr < 16; ++rr) { o0[rr] = 0.f; o1[rr] = 0.f; }
#define VTR(off_) __builtin_bit_cast(s16x4, __builtin_amdgcn_ds_read_tr16_b64_v4i16((LAS s16x4*)(vb + (off_))))
#define MKA(lo_, hi_) (bf16x8){lo_[0], lo_[1], lo_[2], lo_[3], hi_[0], hi_[1], hi_[2], hi_[3]}
#pragma unroll
        for (int n = 0; n < 5; ++n) {
            if (n < nt) {
                LAS unsigned char* vb = VW + (wave + 4 - n) * 4096;
                const bf16x8 p0 = __builtin_bit_cast(bf16x8, pw[n][0]), p1 = __builtin_bit_cast(bf16x8, pw[n][1]);
                const s16x4 l0 = VTR(va0), h0 = VTR(va0 + 8 * 128), l1 = VTR(va0 + 16 * 128), h1 = VTR(va0 + 24 * 128);
                const s16x4 l2 = VTR(va1), h2 = VTR(va1 + 8 * 128), l3 = VTR(va1 + 16 * 128), h3 = VTR(va1 + 24 * 128);
                o0 = __builtin_amdgcn_mfma_f32_32x32x16_bf16(MKA(l0, h0), p0, o0, 0, 0, 0);
                o0 = __builtin_amdgcn_mfma_f32_32x32x16_bf16(MKA(l1, h1), p1, o0, 0, 0, 0);
                o1 = __builtin_amdgcn_mfma_f32_32x32x16_bf16(MKA(l2, h2), p0, o1, 0, 0, 0);
                o1 = __builtin_amdgcn_mfma_f32_32x32x16_bf16(MKA(l3, h3), p1, o1, 0, 0, 0);
            }
        }
#undef VTR
#undef MKA
        const float l_tot = lsum + __shfl_xor(lsum, 32), inv = 1.0f / l_tot;
        bf16* orow = OBR + (size_t)r * M * DATT + (rowb + tq) * DATT + h * HD + 4 * hi;
#pragma unroll
        for (int rg = 0; rg < 4; ++rg) {
            u32x2 w0, w1;
            w0.x = cvtpk(o0[4 * rg] * inv, o0[4 * rg + 1] * inv); w0.y = cvtpk(o0[4 * rg + 2] * inv, o0[4 * rg + 3] * inv);
            w1.x = cvtpk(o1[4 * rg] * inv, o1[4 * rg + 1] * inv); w1.y = cvtpk(o1[4 * rg + 2] * inv, o1[4 * rg + 3] * inv);
            *(u32x2*)(orow + 8 * rg) = w0; *(u32x2*)(orow + 32 + 8 * rg) = w1; }
        if (hi == 0) { f32x2_t ml = {mx, l_tot}; *(f32x2_t*)(ML + (size_t)r * M * NH * 2 + ((rowb + tq) * NH + h) * 2) = ml; }
    }
    __syncthreads();
}

#define XB_TMO      128
#define XB_XCNT(j)  (256  + 64 * (j))
#define XB_XSUB(j)  (1280 + 64 * (j))
#define XB_XGEN(j)  (2304 + 64 * (j))
#define XB_TOP      3328
#define XB_TOPGEN   3392
#define XCD_BAR_WORDS 3456
#define XB_SPIN_CAP (1u << 18)

__device__ __forceinline__ unsigned xb_ld(unsigned* p)              { return __hip_atomic_load(p, __ATOMIC_RELAXED, __HIP_MEMORY_SCOPE_AGENT); }
__device__ __forceinline__ unsigned xb_add(unsigned* p, unsigned v) { return __hip_atomic_fetch_add(p, v, __ATOMIC_RELAXED, __HIP_MEMORY_SCOPE_AGENT); }
__device__ __forceinline__ unsigned xb_xcc_id() { return (unsigned)__builtin_amdgcn_s_getreg((3 << 11) | 20) & 0xFu; }
#define XB_SPIN(cond, bar) do { unsigned _sp = 0; while (cond) { __builtin_amdgcn_s_sleep(1); \
    if ((++_sp & 255u) == 0u) { if (xb_ld(&(bar)[XB_TMO])) break; if (_sp > XB_SPIN_CAP) { atomicAdd(&(bar)[XB_TMO], 1u); break; } } } } while (0)

struct XcdBarrier {
    unsigned* bar; unsigned x;
    volatile LAS unsigned* st;
};

__device__ __forceinline__ XcdBarrier xcd_barrier_post(unsigned* bar, volatile LAS unsigned* st) {
    XcdBarrier b; b.bar = bar; b.x = xb_xcc_id(); b.st = st;
    if (threadIdx.x == 0) (void)xb_add(&bar[XB_XCNT(b.x)], 1u);
    return b;
}
__device__ __forceinline__ void xcd_barrier_complete(unsigned* bar, unsigned x, unsigned& nloc, unsigned& nx) {
    const unsigned G = gridDim.x * gridDim.y * gridDim.z;
    unsigned sum, cnt, mine, sp = 0u;
    for (;;) {
        sum = 0u; cnt = 0u; mine = 0u;
#pragma unroll
        for (unsigned j = 0; j < 16; ++j) { const unsigned c = xb_ld(&bar[XB_XCNT(j)]); sum += c; cnt += (c > 0u) ? 1u : 0u; mine = (j == x) ? c : mine; }
        if (sum == G) break;
        __builtin_amdgcn_s_sleep(1);
        if ((++sp & 255u) == 0u) { if (xb_ld(&bar[XB_TMO])) break; if (sp > XB_SPIN_CAP) { atomicAdd(&bar[XB_TMO], 1u); break; } }
    }
    nloc = mine > 0u ? mine : 1u; nx = cnt > 0u ? cnt : 1u;
}

__device__ __forceinline__ void xcd_barrier(const XcdBarrier& b) {
    asm volatile("s_waitcnt vmcnt(0)" ::: "memory");
    __syncthreads();
    if (threadIdx.x == 0) {
        unsigned* bar = b.bar;
        __builtin_amdgcn_s_waitcnt(0);
        unsigned nloc = b.st[0], nx = b.st[1];
        if (nloc == 0u) { xcd_barrier_complete(bar, b.x, nloc, nx); b.st[0] = nloc; b.st[1] = nx; }
        const unsigned old = xb_add(&bar[XB_XSUB(b.x)], 1u);
        const unsigned gen = old / nloc;
        if (old + 1u == (gen + 1u) * nloc) {
            __builtin_amdgcn_fence(__ATOMIC_RELEASE, "agent");
            asm volatile("s_waitcnt vmcnt(0)" ::: "memory");
            const unsigned og = xb_add(&bar[XB_TOP], 1u);
            const unsigned tg = og / nx;
            if (og + 1u == (tg + 1u) * nx) xb_add(&bar[XB_TOPGEN], 1u);
            else XB_SPIN(xb_ld(&bar[XB_TOPGEN]) == tg, bar);
            __builtin_amdgcn_fence(__ATOMIC_ACQUIRE, "agent");
            asm volatile("s_waitcnt vmcnt(0)" ::: "memory");
        } else {
            XB_SPIN(xb_ld(&bar[XB_TOPGEN]) == gen, bar);
            __builtin_amdgcn_fence(__ATOMIC_ACQUIRE, "agent");
            asm volatile("s_waitcnt vmcnt(0)" ::: "memory");
        }
    }
    __syncthreads();
}

constexpr int LDS_BYTES = 147456;
struct Args { const float* in[18]; float* out; unsigned char* ws; int ph_lo, ph_hi; };
enum { PH_PRO = 0, PH_N1, PH_GU1, PH_DN1, PH_ZIN, PH_ATT, PH_MRG, PH_WOUT, PH_GU2, PH_DN2, PH_COUNT };

__global__ void __launch_bounds__(NTHREADS, 2) fwd_megakernel(Args a) {
    extern __shared__ __attribute__((aligned(16))) unsigned char lds_raw[];
    LAS unsigned char* lds = (LAS unsigned char*)lds_raw;
    cg::grid_group grid = cg::this_grid();
    unsigned char* ws = a.ws;
    const float *x = a.in[0], *c = a.in[1], *w_ada = a.in[2], *b_ada = a.in[3], *g_ffn1 = a.in[4], *g_mix = a.in[8], *g_ffn2 = a.in[13], *g_final = a.in[17];
    float* mod = (float*)(ws + WS_MOD);
    bf16 *W1GU = (bf16*)(ws + WS_W1GU), *W1D = (bf16*)(ws + WS_W1D), *WIN = (bf16*)(ws + WS_WIN), *WOUT = (bf16*)(ws + WS_WOUT), *W2GU = (bf16*)(ws + WS_W2GU), *W2D = (bf16*)(ws + WS_W2D);
    bf16 *XN = (bf16*)(ws + WS_XN), *HID = (bf16*)(ws + WS_HID), *Z = (bf16*)(ws + WS_Z), *OBR = (bf16*)(ws + WS_OBR), *YC = (bf16*)(ws + WS_YC);
    float* ML = (float*)(ws + WS_ML);
    float* SSQ = (float*)(ws + WS_SSQ);
    float *BIAS1 = (float*)(ws + WS_BIAS), *BIASZ = BIAS1 + 2 * 2 * DFF * 2 / 2, *BIAS2 = BIASZ + 2 * DZ;
    bf16* HB = (bf16*)(ws + WS_HB);
    const int G = gridDim.x, bx = blockIdx.x;
    const int lo = a.ph_lo, hi = a.ph_hi;
    volatile LAS unsigned* MISC = (volatile LAS unsigned*)(lds + 131072);
    if (threadIdx.x < 64) MISC[threadIdx.x] = 0u;
    __syncthreads();
    XcdBarrier bar = xcd_barrier_post((unsigned*)(ws + WS_BAR), MISC + 8);
    const WPtrs WP{a.in[5], a.in[6], a.in[7], a.in[9], a.in[10], a.in[11], a.in[12], a.in[14], a.in[15], a.in[16], W1GU, W1D, WIN, WOUT, W2GU, W2D};
    const bool defer_late = (G == 256) && (lo == 0) && (hi == PH_COUNT);
#define IN(k) (lo <= (k) && (k) < hi)
#define GSYNC() do { __syncthreads(); grid.sync(); } while (0)
#define XSYNC() xcd_barrier(bar)
#define SEAM(k) do { if (IN(k) && IN((k) + 1)) XSYNC(); } while (0)
    if (lo > hi) GSYNC();
#ifndef DUP_MASK
#define DUP_MASK 0
#endif
#ifndef EXTRA_SYNCS
#define EXTRA_SYNCS 0
#endif
#define RUNPH(k, BODY) do { if (IN(k)) { BODY; if ((DUP_MASK >> (k)) & 1) { XSYNC(); BODY; } } SEAM(k); } while (0)
#define BODY_PRO { ada_phase(c, w_ada, b_ada, mod, lds); \
        for (int i = bx * NTHREADS + threadIdx.x; i < 3 * M; i += G * NTHREADS) SSQ[M + i] = 0.f; \
        for (int i = bx * NTHREADS + threadIdx.x; i < 64 * 64; i += G * NTHREADS) ((unsigned*)(ws + WS_CNT))[i] = 0u; \
        weights_early(WP, lds); if (!defer_late) weights_late(WP, 0, lds); }
#define BODY_N1 { prep_rows_phase(x, g_ffn1, mod + 1 * D, XN, SSQ); \
        const int gw_ = bx * NWAVES + (threadIdx.x >> 6), NGW_ = G * NWAVES, ln_ = threadIdx.x & 63; \
        bias_rows(W1GU, 2 * DFF, mod + 0 * D, BIAS1, gw_, NGW_, ln_); }
#define BODY_GU(WGU, SSQ_, BIAS_) { pg8::Gemm g{XN, WGU, M, 2 * DFF, D}; pg8::StaticOrder S; S.init(M, 2 * DFF, G, bx); pg8::EpiSwiGLU E{HID, DFF, SSQ_, BIAS_, 2 * DFF, SEQ}; \
        pg8::gemm_phase<pg8::EpiSwiGLU, pg8::StaticOrder, true, true>(lds, g, S, E); }
#define BODY_RES(NEXT_, RESBF_, A_, W_, K_, RES_, MIDX, F_, SSQO_, GN_, SCN_) { pg8::Gemm g{A_, W_, M, D, K_}; pg8::StaticOrder S; S.init(M, D, G, bx); \
        pg8::EpiResid<NEXT_, RESBF_, true> E{RES_, HB, mod + (MIDX) * D, NMOD * D, F_, D, SEQ, SSQO_, XN, GN_, SCN_}; \
        pg8::gemm_phase<pg8::EpiResid<NEXT_, RESBF_, true>, pg8::StaticOrder, true, true>(lds, g, S, E); }
#define BODY_ZIN { pg8::Gemm g{XN, WIN, M, DZ, D}; pg8::StaticOrder S; S.init(M, DZ, G, bx); pg8::EpiZ E{Z, DZ, 2, 4, QSCALE, SSQ + M, BIASZ, DZ, SEQ}; \
        pg8::gemm_phase<pg8::EpiZ, pg8::StaticOrder, true, true>(lds, g, S, E); }
    RUNPH(PH_PRO, BODY_PRO);
    for (int i = 0; i < EXTRA_SYNCS; ++i) XSYNC();
    RUNPH(PH_N1, BODY_N1);
    RUNPH(PH_GU1, { BODY_GU(W1GU, SSQ, BIAS1); if (defer_late) weights_late(WP, 128, lds); });
#if defined(PROBE_DN1)
    if (IN(PH_DN1)) { BODY_RES(true, false, HID, W1D, DFF, x, 2, 0.5f, (float*)(ws + WS_YC), g_mix, mod + 4 * D); XSYNC(); }
#endif
#define BODY_BIASZ { const int gw_ = bx * NWAVES + (threadIdx.x >> 6), NGW_ = G * NWAVES, ln_ = threadIdx.x & 63; bias_rows(WIN, DZ, mod + 3 * D, BIASZ, gw_, NGW_, ln_); }
#define BODY_BIAS2 { const int gw_ = bx * NWAVES + (threadIdx.x >> 6), NGW_ = G * NWAVES, ln_ = threadIdx.x & 63; bias_rows(W2GU, 2 * DFF, mod + 6 * D, BIAS2, gw_, NGW_, ln_); }
    RUNPH(PH_DN1, { BODY_BIASZ; BODY_RES(true, false, HID, W1D, DFF, x, 2, 0.5f, SSQ + M, g_mix, mod + 4 * D); });
    RUNPH(PH_ZIN, BODY_ZIN);
    RUNPH(PH_ATT, { BODY_BIAS2; attn_phase(Z, OBR, ML, YC, lds); });
    RUNPH(PH_MRG, merge_phase(Z, OBR, ML, YC));
    RUNPH(PH_WOUT, BODY_RES(true, true, YC, WOUT, D, HB, 5, 1.0f, SSQ + 2 * M, g_ffn2, mod + 7 * D));
    RUNPH(PH_GU2, BODY_GU(W2GU, SSQ + 2 * M, BIAS2));
#define BODY_DN2 { pg8::Gemm g{HID, W2D, M, D, DFF}; pg8::StaticOrder S; S.init(M, D, G, bx); \
        if (G == 256) { pg8::EpiResidFinal E{HB, a.out, mod + 8 * D, NMOD * D, 0.5f, D, SEQ, SSQ + 3 * M, (unsigned*)(ws + WS_CNT), g_final, 32u}; \
            pg8::gemm_phase<pg8::EpiResidFinal, pg8::StaticOrder, true, true>(lds, g, S, E); } \
        else {     \
            pg8::EpiResid<false, true, false> E{HB, a.out, mod + 8 * D, NMOD * D, 0.5f, D, SEQ, SSQ + 3 * M, XN, g_final, mod}; \
            pg8::gemm_phase<pg8::EpiResid<false, true, false>, pg8::StaticOrder, true, true>(lds, g, S, E); \
            XSYNC(); final_norm_phase(a.out, g_final, SSQ + 3 * M, a.out); } }
    RUNPH(PH_DN2, BODY_DN2);
#undef IN
}

#ifndef MK_COOP
#define MK_COOP 1
#endif
extern "C" void kernel_launch(void* const* d_in, const int* in_sizes, int n_in, void* d_out, int out_size, void* d_ws, size_t ws_size, hipStream_t stream) {
    static int grid = 0;
    if (grid == 0) {
        if (n_in != 18 || in_sizes[0] != M * D || out_size != M * D || ws_size < WS_END) { fprintf(stderr, "kernel_launch: unexpected shapes (n_in %d, in0 %d, out %d, ws %zu)\n", n_in, n_in > 0 ? in_sizes[0] : -1, out_size, ws_size); grid = -1; return; }
        int dev = 0, cus = 0, per_cu = 0;
        if (hipGetDevice(&dev) != hipSuccess || hipDeviceGetAttribute(&cus, hipDeviceAttributeMultiprocessorCount, dev) != hipSuccess) { grid = -1; return; }
        if (hipFuncSetAttribute((const void*)fwd_megakernel, hipFuncAttributeMaxDynamicSharedMemorySize, LDS_BYTES) != hipSuccess) { fprintf(stderr, "kernel_launch: hipFuncSetAttribute failed\n"); grid = -1; return; }
        if (hipOccupancyMaxActiveBlocksPerMultiprocessor(&per_cu, (const void*)fwd_megakernel, NTHREADS, LDS_BYTES) != hipSuccess || per_cu < 1) { fprintf(stderr, "kernel_launch: occupancy query says %d\n", per_cu); per_cu = 1; }
        (void)hipGetLastError();
        grid = cus * 1;
        if (grid > cus * per_cu) grid = cus * per_cu;
    }
    if (grid < 0) return;
    if (hipMemsetAsync((char*)d_ws + WS_MOD, 0, WS_BAR + WS_BAR_BYTES - WS_MOD, stream) != hipSuccess) { fprintf(stderr, "kernel_launch: memset failed\n"); return; }
    Args a{};
    for (int i = 0; i < 18; ++i) a.in[i] = (const float*)d_in[i];
    a.out = (float*)d_out; a.ws = (unsigned char*)d_ws;
#if MK_COOP
    a.ph_lo = 0; a.ph_hi = PH_COUNT;
    void* args[] = {&a};
    hipError_t e = hipLaunchCooperativeKernel((const void*)fwd_megakernel, dim3(grid), dim3(NTHREADS), args, LDS_BYTES, stream);
    if (e != hipSuccess) fprintf(stderr, "cooperative launch failed: %s (grid %d)\n", hipGetErrorString(e), grid);
#else
    for (int ph = 0; ph < PH_COUNT; ++ph) { a.ph_lo = ph; a.ph_hi = ph + 1; hipLaunchKernelGGL(fwd_megakernel, dim3(grid), dim3(NTHREADS), LDS_BYTES, stream, a); }
#endif
}
```
